# Optimizing an MI355X kernel written in HIP

```python
import numpy as np
import jax
import jax.numpy as jnp
from jax import lax

D_MODEL = 1024
BATCH = 32
SEQ = 2048
DEPTH = 2

HEAD_DIM = 64
N_HEADS_TOTAL = D_MODEL // HEAD_DIM
NSA_HEADS = N_HEADS_TOTAL // 4
FOX_HEADS = (N_HEADS_TOTAL - NSA_HEADS) // 2
SB_HEADS = N_HEADS_TOTAL - NSA_HEADS - FOX_HEADS
NSA_KV_HEADS = 1
NSA_GROUP = NSA_HEADS // NSA_KV_HEADS
FOX_W = FOX_HEADS * HEAD_DIM
SB_W = SB_HEADS * HEAD_DIM
NSA_W = NSA_HEADS * HEAD_DIM
NSA_KV_W = NSA_KV_HEADS * HEAD_DIM
D_MIX = FOX_W + SB_W + NSA_W
CMP_BLOCK = 32
CMP_STRIDE = 16
SEL_BLOCK = 64
SEL_TOPK = 8
SEL_N_LOCAL = 2
WINDOW = 512
Q_BLOCK = 128
NORM_EPS = 1e-6
SPLIT_SIZES = (FOX_W, FOX_W, FOX_W, FOX_HEADS, FOX_W,
               SB_W, SB_W, SB_W, SB_W,
               NSA_W, NSA_KV_W, NSA_KV_W, NSA_KV_W, NSA_KV_W, NSA_KV_W, NSA_KV_W,
               3 * NSA_HEADS, NSA_W)
D_IN = sum(SPLIT_SIZES)

kernel_name = 'hybrid_fox_stickbreak_nsa_block'


def rms_norm(x, g):
    xf = x.astype(jnp.float32)
    ms = jnp.mean(xf * xf, axis=-1, keepdims=True)
    return (xf * lax.rsqrt(ms + NORM_EPS) * g.astype(jnp.float32)).astype(x.dtype)


def masked_softmax(logits, mask):
    logits = jnp.where(mask, logits, -jnp.inf)
    m = jnp.max(logits, axis=-1, keepdims=True)
    m = jnp.where(jnp.isfinite(m), m, 0.0)
    p = jnp.exp(logits - m)
    s = jnp.sum(p, axis=-1, keepdims=True)
    return p / jnp.where(s > 0, s, 1.0)


def alibi_slopes(n):
    return 2.0 ** (-8.0 * jnp.arange(1, n + 1, dtype=jnp.float32) / n)


def fox_attention(q, k, v, f_logit):
    B, S, H, dh = q.shape
    scale = dh ** -0.5
    c = jnp.cumsum(jax.nn.log_sigmoid(f_logit.astype(jnp.float32)), axis=1).transpose(0, 2, 1)
    kpos = jnp.arange(S)

    def block(i):
        qs = i * Q_BLOCK
        qb = lax.dynamic_slice_in_dim(q, qs, Q_BLOCK, axis=1)
        cq = lax.dynamic_slice_in_dim(c, qs, Q_BLOCK, axis=2)
        tpos = qs + jnp.arange(Q_BLOCK)
        s = (jnp.einsum('bqhd,bkhd->bhqk', qb, k).astype(jnp.float32) * scale
             + cq[..., None] - c[:, :, None, :])
        p = masked_softmax(s, kpos[None, :] <= tpos[:, None])
        return jnp.einsum('bhqk,bkhd->bqhd', p.astype(v.dtype), v)

    out = lax.map(block, jnp.arange(S // Q_BLOCK))
    return out.transpose(1, 0, 2, 3, 4).reshape(B, S, H, dh)


def stick_breaking_attention(q, k, v):
    B, S, H, dh = q.shape
    scale = dh ** -0.5
    kpos = jnp.arange(S)

    def block(i):
        qs = i * Q_BLOCK
        qb = lax.dynamic_slice_in_dim(q, qs, Q_BLOCK, axis=1)
        tpos = qs + jnp.arange(Q_BLOCK)
        z = jnp.einsum('bqhd,bkhd->bhqk', qb, k).astype(jnp.float32) * scale
        mask = kpos[None, :] < tpos[:, None]
        log_1m = jnp.where(mask, jax.nn.log_sigmoid(-z), 0.0)
        between = lax.cumsum(log_1m, axis=3, reverse=True) - log_1m
        a = jnp.where(mask, jnp.exp(jax.nn.log_sigmoid(z) + between), 0.0)
        return jnp.einsum('bhqk,bkhd->bqhd', a.astype(v.dtype), v)

    out = lax.map(block, jnp.arange(S // Q_BLOCK))
    return out.transpose(1, 0, 2, 3, 4).reshape(B, S, H, dh)


def compress_blocks(kv, pos_emb, w1, w2, idx):
    B = kv.shape[0]
    n_cmp = idx.shape[0]
    blk = kv[:, idx] + pos_emb[None, None, :, None, :]
    blk = blk.transpose(0, 1, 3, 2, 4).reshape(B, n_cmp, NSA_KV_HEADS, CMP_BLOCK * HEAD_DIM)
    hid = jax.nn.silu(jnp.einsum('bnhf,fe->bnhe', blk, w1))
    return jnp.einsum('bnhe,ed->bnhd', hid, w2)


def nsa_attention(q, k_cmp, v_cmp, k_slc, v_slc, k_win, v_win, gates,
                  pos_k, w1_k, w2_k, pos_v, w1_v, w2_v, slopes):
    B, S = q.shape[0], q.shape[1]
    Hkv, G, dh = NSA_KV_HEADS, NSA_GROUP, HEAD_DIM
    scale = dh ** -0.5
    dt = q.dtype
    n_cmp = (S - CMP_BLOCK) // CMP_STRIDE + 1
    n_sel = S // SEL_BLOCK
    k_top = min(SEL_TOPK, n_sel)
    idx = np.arange(n_cmp)[:, None] * CMP_STRIDE + np.arange(CMP_BLOCK)[None, :]
    cmp_end = jnp.asarray(idx[:, -1])
    cs, ce = idx[:, 0], idx[:, -1]
    ss = np.arange(n_sel) * SEL_BLOCK
    se = ss + SEL_BLOCK - 1
    cmp_to_sel = jnp.asarray(((cs[:, None] <= se[None, :]) & (ce[:, None] >= ss[None, :])).astype(np.float32))
    kc = compress_blocks(k_cmp, pos_k, w1_k, w2_k, idx)
    vc = compress_blocks(v_cmp, pos_v, w1_v, w2_v, idx)
    ksb = k_slc.reshape(B, n_sel, SEL_BLOCK, Hkv, dh).transpose(0, 3, 1, 2, 4)
    vsb = v_slc.reshape(B, n_sel, SEL_BLOCK, Hkv, dh).transpose(0, 3, 1, 2, 4)
    pad = ((0, 0), (WINDOW, 0), (0, 0), (0, 0))
    kwp = jnp.pad(k_win, pad)
    vwp = jnp.pad(v_win, pad)
    bi = jnp.arange(B)[:, None, None, None]
    hi = jnp.arange(Hkv)[None, :, None, None]
    blk_id = jnp.arange(n_sel)
    sl = slopes[:, :, None, None]

    def block(i):
        qs = i * Q_BLOCK
        qb = lax.dynamic_slice_in_dim(q, qs, Q_BLOCK, axis=1)
        tpos = qs + jnp.arange(Q_BLOCK)
        dist_c = (tpos[:, None] - cmp_end[None, :]).astype(jnp.float32)
        s_c = jnp.einsum('bqhgd,bnhd->bhgqn', qb, kc).astype(jnp.float32) * scale - sl * dist_c
        p_c = masked_softmax(s_c, dist_c >= 0)
        o_c = jnp.einsum('bhgqn,bnhd->bqhgd', p_c.astype(dt), vc)
        imp = jnp.einsum('bhgqn,nj->bhqj', p_c, cmp_to_sel)
        cur = tpos // SEL_BLOCK
        back = cur[:, None] - blk_id[None, :]
        valid = back >= 0
        forced = (blk_id[None, :] == 0) | (valid & (back < SEL_N_LOCAL))
        imp = jnp.where(forced, jnp.inf, jnp.where(valid, imp, -jnp.inf))
        _, sel = lax.top_k(imp, k_top)
        kg = ksb[bi, hi, sel].reshape(B, Hkv, Q_BLOCK, k_top * SEL_BLOCK, dh)
        vg = vsb[bi, hi, sel].reshape(B, Hkv, Q_BLOCK, k_top * SEL_BLOCK, dh)
        kp = (sel[..., None] * SEL_BLOCK + jnp.arange(SEL_BLOCK)).reshape(B, Hkv, Q_BLOCK, k_top * SEL_BLOCK)
        dist_s = (tpos[None, None, :, None] - kp).astype(jnp.float32)[:, :, None]
        qh = qb.transpose(0, 2, 3, 1, 4)
        s_s = (jnp.einsum('bhgqd,bhqkd->bhgqk', qh, kg).astype(jnp.float32) * scale
               - slopes[None, :, :, None, None] * dist_s)
        p_s = masked_softmax(s_s, dist_s >= 0)
        o_s = jnp.einsum('bhgqk,bhqkd->bqhgd', p_s.astype(dt), vg)
        kw = lax.dynamic_slice_in_dim(kwp, qs, WINDOW + Q_BLOCK, axis=1)
        vw = lax.dynamic_slice_in_dim(vwp, qs, WINDOW + Q_BLOCK, axis=1)
        wpos = qs - WINDOW + jnp.arange(WINDOW + Q_BLOCK)
        dist_w = tpos[:, None] - wpos[None, :]
        mask_w = (wpos[None, :] >= 0) & (dist_w >= 0) & (dist_w < WINDOW)
        s_w = (jnp.einsum('bqhgd,bkhd->bhgqk', qb, kw).astype(jnp.float32) * scale
               - sl * dist_w.astype(jnp.float32))
        p_w = masked_softmax(s_w, mask_w)
        o_w = jnp.einsum('bhgqk,bkhd->bqhgd', p_w.astype(dt), vw)
        g = lax.dynamic_slice_in_dim(gates, qs, Q_BLOCK, axis=1).astype(dt)
        return o_c * g[..., 0:1] + o_s * g[..., 1:2] + o_w * g[..., 2:3]

    out = lax.map(block, jnp.arange(S // Q_BLOCK))
    return out.transpose(1, 0, 2, 3, 4, 5).reshape(B, S, NSA_W)


def setup_inputs(seed: int = 0) -> dict:
    key = jax.random.key(seed)
    ks = jax.random.split(key, 14)
    f32 = jnp.float32
    lf = CMP_BLOCK * HEAD_DIM
    x = jax.random.normal(ks[0], (BATCH, SEQ, D_MODEL), f32)
    norm_g = 1.0 + 0.01 * jax.random.normal(ks[1], (DEPTH, D_MODEL), f32)
    w_in = jax.random.normal(ks[2], (DEPTH, D_MODEL, D_IN), f32) * D_MODEL ** -0.5
    b_f = 2.0 + 0.1 * jax.random.normal(ks[3], (DEPTH, FOX_HEADS), f32)
    cmp_pos_k = 0.02 * jax.random.normal(ks[4], (DEPTH, CMP_BLOCK, HEAD_DIM), f32)
    cmp_w1_k = jax.random.normal(ks[5], (DEPTH, lf, HEAD_DIM), f32) * lf ** -0.5
    cmp_w2_k = jax.random.normal(ks[6], (DEPTH, HEAD_DIM, HEAD_DIM), f32) * HEAD_DIM ** -0.5
    cmp_pos_v = 0.02 * jax.random.normal(ks[7], (DEPTH, CMP_BLOCK, HEAD_DIM), f32)
    cmp_w1_v = jax.random.normal(ks[8], (DEPTH, lf, HEAD_DIM), f32) * lf ** -0.5
    cmp_w2_v = jax.random.normal(ks[9], (DEPTH, HEAD_DIM, HEAD_DIM), f32) * HEAD_DIM ** -0.5
    w_out = jax.random.normal(ks[10], (DEPTH, D_MIX, D_MODEL), f32) * D_MIX ** -0.5
    final_g = 1.0 + 0.01 * jax.random.normal(ks[11], (D_MODEL,), f32)
    return {'x': x, 'norm_g': norm_g, 'w_in': w_in, 'b_f': b_f,
            'cmp_pos_k': cmp_pos_k, 'cmp_w1_k': cmp_w1_k, 'cmp_w2_k': cmp_w2_k,
            'cmp_pos_v': cmp_pos_v, 'cmp_w1_v': cmp_w1_v, 'cmp_w2_v': cmp_w2_v,
            'w_out': w_out, 'final_g': final_g}


def reference(x, norm_g, w_in, b_f, cmp_pos_k, cmp_w1_k, cmp_w2_k,
              cmp_pos_v, cmp_w1_v, cmp_w2_v, w_out, final_g):
    B, S, _ = x.shape
    offsets = np.cumsum(SPLIT_SIZES)[:-1].tolist()
    slopes = alibi_slopes(NSA_HEADS).reshape(NSA_KV_HEADS, NSA_GROUP)

    def heads(t, n):
        return t.reshape(B, S, n, HEAD_DIM)

    def kv_heads(t):
        return t.reshape(B, S, NSA_KV_HEADS, HEAD_DIM)

    for l in range(DEPTH):
        h = rms_norm(x, norm_g[l])
        proj = jnp.einsum('bsd,de->bse', h, w_in[l])
        (fq, fk, fv, ff, fz, sq, sk, sv, sz,
         nq, nkc, nvc, nks, nvs, nkw, nvw, ng, nz) = jnp.split(proj, offsets, axis=-1)
        o_fox = fox_attention(heads(fq, FOX_HEADS), heads(fk, FOX_HEADS), heads(fv, FOX_HEADS),
                              ff + b_f[l]).reshape(B, S, FOX_W) * jax.nn.silu(fz)
        o_sb = stick_breaking_attention(heads(sq, SB_HEADS), heads(sk, SB_HEADS),
                                        heads(sv, SB_HEADS)).reshape(B, S, SB_W) * jax.nn.silu(sz)
        gates = jax.nn.sigmoid(ng.astype(jnp.float32)).reshape(B, S, NSA_KV_HEADS, NSA_GROUP, 3)
        o_nsa = nsa_attention(nq.reshape(B, S, NSA_KV_HEADS, NSA_GROUP, HEAD_DIM),
                              kv_heads(nkc), kv_heads(nvc), kv_heads(nks), kv_heads(nvs),
                              kv_heads(nkw), kv_heads(nvw), gates,
                              cmp_pos_k[l], cmp_w1_k[l], cmp_w2_k[l],
                              cmp_pos_v[l], cmp_w1_v[l], cmp_w2_v[l], slopes) * jax.nn.silu(nz)
        mixed = jnp.concatenate([o_fox, o_sb, o_nsa], axis=-1)
        x = x + jnp.einsum('bse,ed->bsd', mixed, w_out[l])
    return rms_norm(x, final_g)
```

```cpp
#include <hip/hip_runtime.h>
#include <hip/hip_cooperative_groups.h>
#include <cstdio>
#include <cstdint>
namespace cg = cooperative_groups;
namespace pg8 {
#define PG8_LAS __attribute__((address_space(3)))
typedef unsigned short bf16_t;
typedef short bf16x8 __attribute__((ext_vector_type(8)));
typedef float f32x4 __attribute__((ext_vector_type(4)));
typedef unsigned u32x4 __attribute__((ext_vector_type(4)));
constexpr int BM = 256, BK = 64, HALF = 128, HTB = HALF * BK * 2  , STAGE_BYTES = 8 * HTB, NXCD = 8, WGM = 8;

__host__ __device__ __forceinline__ int lds_byte(int r, int c) { const int st = (r >> 4) * 2 + (c >> 5), rr = r & 15, cc = c & 31, ob = rr * 64 + cc * 2; return st * 1024 + (ob ^ (((ob >> 9) & 1) << 5)); }
__host__ __device__ __forceinline__ void stage_rc(int b, int& R, int& C) { const int st = b / 1024, sb = b % 1024, swz = sb ^ (((sb >> 9) & 1) << 5); R = (st >> 1) * 16 + swz / 64; C = (st & 1) * 32 + (swz % 64) / 2; }
__host__ __device__ __forceinline__ int perm32(int rho) { const int n = rho >> 4, i = rho & 15; return 8 * (i >> 2) + 4 * n + (i & 3); }

struct Unit { int pm, pn; };
struct Gemm { const bf16_t* A; const bf16_t* Bt; int M, N, K; };

struct StaticOrder {
    int nM, nN, nwg, G, c;
    __host__ __device__ void init(int M, int N, int G_, int c_) { nM = M / BM; nN = N / BM; nwg = nM * nN; G = G_; c = c_; }
    __host__ __device__ bool next(int i, Unit& u) const {
        const long L = (long)i * G + c; if (L >= nwg) return false;
        int wgid = (int)L; { const int q = nwg / NXCD, r = nwg % NXCD, xcd = wgid % NXCD, off = wgid / NXCD; wgid = (xcd < r ? xcd * (q + 1) : r * (q + 1) + (xcd - r) * q) + off; }
        const int nig = WGM * nN, gid = wgid / nig, fm = gid * WGM, gsz = (nM - fm) < WGM ? (nM - fm) : WGM;
        u.pm = fm + ((wgid % nig) % gsz); u.pn = (wgid % nig) / gsz; return true;
    }
    __device__ __forceinline__ void a_ready(const Unit&) const {}
    __device__ __forceinline__ void done(const Unit&) const {}
};

__device__ __forceinline__ unsigned cvt_pk_bf16(float lo, float hi) { unsigned r; asm volatile("v_cvt_pk_bf16_f32 %0, %1, %2" : "=v"(r) : "v"(lo), "v"(hi)); return r; }
template <class Epi, class Sched, bool ALIGN_EPI = false, bool SP2 = false>
__device__ __forceinline__ void gemm_phase(PG8_LAS unsigned char* lds, const Gemm g, const Sched& S, const Epi& E) {
    int tid_ = threadIdx.x; asm volatile("" : "+v"(tid_)); const int tid = tid_, wid = __builtin_amdgcn_readfirstlane(tid >> 6), lane = tid & 63, wr = wid >> 2, wc = wid & 3, fr = lane & 15, fq = lane >> 4;
    const int K = g.K, nt = K / BK;
    unsigned voffA[2], voffB[2];
#pragma unroll
    for (int i = 0; i < 2; ++i) { int R, C; stage_rc(tid * 16 + i * 8192, R, C); const int Rb = Epi::PERM ? ((R & ~31) + perm32(R & 31)) : R;
        voffA[i] = (unsigned)(R * K + C) * 2u; voffB[i] = (unsigned)(Rb * K + C) * 2u; }
    const size_t kstep = (size_t)(BK * 2);
    const size_t hstep = (size_t)HALF * K * 2;
    const size_t tstep = 2 * hstep;
    const unsigned ldsw = (unsigned)wid * 1024u;
    const int aoff = lds_byte(wr * 64 + fr, fq * 8), boff = lds_byte(wc * 32 + fr, fq * 8);
#define PG8_SA(b, h) (((b) * 2 + (h)) * HTB)
#define PG8_SB(b, h) ((4 + (b) * 2 + (h)) * HTB)
#define PG8_STAGE(bufoff, gbase, voff) do { _Pragma("unroll") for (int _i = 0; _i < 2; ++_i) \
        __builtin_amdgcn_global_load_lds((const unsigned*)((const char*)(gbase) + (voff)[_i]), (PG8_LAS unsigned*)(lds + (bufoff) + ldsw + _i * 8192), 16, 0, 0); } while (0)
#define PG8_LDA(dst, b, h) do { _Pragma("unroll") for (int m = 0; m < 4; ++m) _Pragma("unroll") for (int k = 0; k < 2; ++k) dst[m][k] = *(const PG8_LAS bf16x8*)(lds + PG8_SA(b, h) + aoff + m * 2048 + k * 1024); } while (0)
#define PG8_LDB(dst, b, h) do { _Pragma("unroll") for (int n = 0; n < 2; ++n) _Pragma("unroll") for (int k = 0; k < 2; ++k) dst[n][k] = *(const PG8_LAS bf16x8*)(lds + PG8_SB(b, h) + boff + n * 2048 + k * 1024); } while (0)
#define PG8_MMA(ai, bj, At, Bt) do { __builtin_amdgcn_s_setprio(1); _Pragma("unroll") for (int m = 0; m < 4; ++m) _Pragma("unroll") for (int n = 0; n < 2; ++n) _Pragma("unroll") for (int k = 0; k < 2; ++k) \
        acc[ai][bj][m][n] = __builtin_amdgcn_mfma_f32_16x16x32_bf16(Bt[n][k], At[m][k], acc[ai][bj][m][n], 0, 0, 0); __builtin_amdgcn_s_setprio(0); } while (0)
#define PG8_WAIT_V(n) asm volatile("s_waitcnt vmcnt(" #n ")" ::: "memory")
#define PG8_WAIT_L(n) asm volatile("s_waitcnt lgkmcnt(" #n ")" ::: "memory")
#define PG8_BAR __builtin_amdgcn_s_barrier()
#define PG8_SCHED __builtin_amdgcn_sched_barrier(0)
    Unit cur, nxt; int ui = 0;
    if (!S.next(0, cur)) return;
    f32x4 acc[2][2][4][2];
#pragma unroll
    for (int a = 0; a < 2; ++a)
#pragma unroll
        for (int b = 0; b < 2; ++b)
#pragma unroll
            for (int m = 0; m < 4; ++m)
#pragma unroll
                for (int n = 0; n < 2; ++n) acc[a][b][m][n] = (f32x4){0.f, 0.f, 0.f, 0.f};
    bf16x8 At[4][2], B0[2][2], B1[2][2];
    const char* cA = (const char*)g.A + (size_t)cur.pm * tstep; const char* cB = (const char*)g.Bt + (size_t)cur.pn * tstep;
    S.a_ready(cur);
    if constexpr (SP2) {
        PG8_STAGE(PG8_SB(0, 0), cB, voffB); PG8_STAGE(PG8_SB(0, 1), cB + hstep, voffB); PG8_STAGE(PG8_SA(0, 0), cA, voffA); PG8_STAGE(PG8_SA(0, 1), cA + hstep, voffA);
        if (wr == 1) PG8_BAR;
        PG8_WAIT_V(2); PG8_BAR;
        PG8_STAGE(PG8_SB(1, 0), cB + kstep, voffB); PG8_STAGE(PG8_SA(1, 0), cA + kstep, voffA); PG8_STAGE(PG8_SB(1, 1), cB + hstep + kstep, voffB);
        PG8_WAIT_V(6); PG8_BAR;
    } else {
        PG8_STAGE(PG8_SB(0, 0), cB, voffB); PG8_STAGE(PG8_SA(0, 0), cA, voffA); PG8_STAGE(PG8_SB(0, 1), cB + hstep, voffB); PG8_STAGE(PG8_SA(0, 1), cA + hstep, voffA);
        if (wr == 1) PG8_BAR;
        PG8_WAIT_V(4); PG8_BAR;
        PG8_STAGE(PG8_SB(1, 0), cB + kstep, voffB); PG8_STAGE(PG8_SA(1, 0), cA + kstep, voffA); PG8_STAGE(PG8_SB(1, 1), cB + hstep + kstep, voffB);
        PG8_WAIT_V(6); PG8_BAR;
    }
    for (;;) {
        const bool has_next = S.next(ui + 1, nxt);
        const char* nA = has_next ? (const char*)g.A + (size_t)nxt.pm * tstep : cA; const char* nB = has_next ? (const char*)g.Bt + (size_t)nxt.pn * tstep : cB;
        for (int t = 0; t < nt; t += 2) {
            const bool last = (t == nt - 2);
            const char* a1 = cA + (size_t)(t + 1) * kstep;
            const char* a2 = last ? nA : cA + (size_t)(t + 2) * kstep; const char* b2 = last ? nB : cB + (size_t)(t + 2) * kstep;
            const char* a3 = a2 + kstep; const char* b3 = b2 + kstep;
            if (last && has_next) S.a_ready(nxt);
            if constexpr (SP2) {
            PG8_LDB(B0, 0, 0); PG8_LDB(B1, 0, 1); PG8_SCHED; PG8_LDA(At, 0, 0); PG8_STAGE(PG8_SA(1, 1), a1 + hstep, voffA);
            PG8_WAIT_V(8); PG8_WAIT_L(0); PG8_BAR; PG8_MMA(0, 0, At, B0); PG8_MMA(0, 1, At, B1); PG8_BAR; PG8_SCHED;
            PG8_LDA(At, 0, 1); PG8_STAGE(PG8_SB(0, 0), b2, voffB); PG8_STAGE(PG8_SB(0, 1), b2 + hstep, voffB); PG8_STAGE(PG8_SA(0, 0), a2, voffA);
            PG8_WAIT_V(8); PG8_WAIT_L(0); PG8_BAR; PG8_MMA(1, 0, At, B0); PG8_MMA(1, 1, At, B1); PG8_BAR; PG8_SCHED;
            PG8_LDB(B0, 1, 0); PG8_LDB(B1, 1, 1); PG8_SCHED; PG8_LDA(At, 1, 0); PG8_STAGE(PG8_SA(0, 1), a2 + hstep, voffA);
            PG8_WAIT_V(8); PG8_WAIT_L(0); PG8_BAR; PG8_MMA(0, 0, At, B0); PG8_MMA(0, 1, At, B1); PG8_BAR; PG8_SCHED;
            PG8_LDA(At, 1, 1); PG8_STAGE(PG8_SB(1, 0), b3, voffB); PG8_STAGE(PG8_SB(1, 1), b3 + hstep, voffB); PG8_STAGE(PG8_SA(1, 0), a3, voffA);
            PG8_WAIT_V(8); PG8_WAIT_L(0); PG8_BAR; PG8_MMA(1, 0, At, B0); PG8_MMA(1, 1, At, B1); PG8_BAR; PG8_SCHED;
            } else {
            PG8_LDB(B0, 0, 0); PG8_SCHED; PG8_LDA(At, 0, 0); PG8_STAGE(PG8_SA(1, 1), a1 + hstep, voffA);
            PG8_WAIT_L(8); PG8_BAR; PG8_WAIT_L(0); PG8_MMA(0, 0, At, B0); PG8_BAR; PG8_SCHED;
            PG8_LDB(B1, 0, 1); PG8_STAGE(PG8_SB(0, 0), b2, voffB);
            PG8_BAR; PG8_WAIT_L(0); PG8_MMA(0, 1, At, B1); PG8_BAR;
            PG8_LDA(At, 0, 1); PG8_STAGE(PG8_SA(0, 0), a2, voffA);
            PG8_BAR; PG8_WAIT_L(0); PG8_MMA(1, 0, At, B0); PG8_BAR; PG8_SCHED;
            PG8_STAGE(PG8_SB(0, 1), b2 + hstep, voffB);
            PG8_WAIT_V(6); PG8_BAR; PG8_MMA(1, 1, At, B1); PG8_BAR;
            PG8_LDB(B0, 1, 0); PG8_SCHED; PG8_LDA(At, 1, 0); PG8_STAGE(PG8_SA(0, 1), a2 + hstep, voffA);
            PG8_WAIT_L(8); PG8_BAR; PG8_WAIT_L(0); PG8_MMA(0, 0, At, B0); PG8_BAR; PG8_SCHED;
            PG8_LDB(B1, 1, 1); PG8_STAGE(PG8_SB(1, 0), b3, voffB);
            PG8_BAR; PG8_WAIT_L(0); PG8_MMA(0, 1, At, B1); PG8_BAR;
            PG8_LDA(At, 1, 1); PG8_STAGE(PG8_SA(1, 0), a3, voffA);
            PG8_BAR; PG8_WAIT_L(0); PG8_MMA(1, 0, At, B0); PG8_BAR; PG8_SCHED;
            PG8_STAGE(PG8_SB(1, 1), b3 + hstep, voffB);
            PG8_WAIT_V(6); PG8_BAR; PG8_MMA(1, 1, At, B1); PG8_BAR;
            }
        }
        if constexpr (ALIGN_EPI) { if (wr == 0) PG8_BAR; }
        if constexpr (!Epi::AFTER_DRAIN) { E(acc, cur, wr, wc, fr, fq); S.done(cur); }
        if (!has_next) break;
#pragma unroll
        for (int a = 0; a < 2; ++a)
#pragma unroll
            for (int b = 0; b < 2; ++b)
#pragma unroll
                for (int m = 0; m < 4; ++m)
#pragma unroll
                    for (int n = 0; n < 2; ++n) acc[a][b][m][n] = (f32x4){0.f, 0.f, 0.f, 0.f};
        cur = nxt; cA = nA; cB = nB; ++ui;
        if constexpr (ALIGN_EPI) { if (wr == 1) PG8_BAR; }
    }
    PG8_WAIT_V(0);
    if constexpr (!ALIGN_EPI) { if (wr == 0) PG8_BAR; }
    PG8_BAR;
    if constexpr (Epi::AFTER_DRAIN) { E.fused(acc, cur, wr, wc, fr, fq, lds, wid, lane); S.done(cur); }
#undef PG8_SA
#undef PG8_SB
#undef PG8_STAGE
#undef PG8_LDA
#undef PG8_LDB
#undef PG8_MMA
#undef PG8_WAIT_V
#undef PG8_WAIT_L
#undef PG8_BAR
#undef PG8_SCHED
}
}

#define LAS __attribute__((address_space(3)))
#define DI __device__ __forceinline__
typedef unsigned short bf16;
typedef short bf16x8 __attribute__((ext_vector_type(8)));
typedef short s16x4 __attribute__((ext_vector_type(4)));
typedef float f32x4 __attribute__((ext_vector_type(4)));
typedef float f32x16 __attribute__((ext_vector_type(16)));
typedef unsigned u32x4 __attribute__((ext_vector_type(4)));
typedef unsigned u32x2 __attribute__((ext_vector_type(2)));
typedef LAS const char* lds_cptr;
typedef short v4i16_t __attribute__((ext_vector_type(4)));
typedef float f32x2_t __attribute__((ext_vector_type(2)));
typedef __bf16 bf16x2_t __attribute__((ext_vector_type(2)));

constexpr int S = 2048, NB = 32, M = NB * S, D = 1024, NP = 4096, DIN = 3986;
constexpr int C_FQ = 0, C_FK = 384, C_FV = 768, C_FZ = 1152, C_SQ = 1536, C_SK = 1920, C_SV = 2304, C_SZ = 2688, C_NQ = 3072, C_NKC = 3328, C_NVC = 3392,
              C_NKS = 3456, C_NVS = 3520, C_NKW = 3584, C_NVW = 3648, C_NZ = 3712;
constexpr size_t MiB = 1u << 20;
constexpr size_t WS_CTL = 0, CTL_BYTES = 32768;
constexpr size_t WS_WTIN = 2 * MiB;
constexpr size_t WS_WTOUT = 18 * MiB;
constexpr size_t WS_W1T = 22 * MiB;
constexpr size_t WS_W2T = 23 * MiB;
constexpr size_t WS_PB = 23 * MiB + 65536;
constexpr size_t WS_KC = 24 * MiB;
constexpr size_t WS_VC = 25 * MiB;
constexpr size_t WS_AUX = 26 * MiB;
constexpr size_t WS_H = 64 * MiB;
constexpr size_t WS_PROJ = 192 * MiB;
constexpr size_t WS_END = 704 * MiB;
constexpr int STG = 18432;
constexpr int L_CBUF = 36864;
constexpr int L_IMP = 45056;
constexpr int L_SELM = 78848;
constexpr int L_MISC = 79104;
constexpr int L_RED = 36864;
constexpr int L_HID = 69632;
constexpr int L_TACC = 81920;
constexpr int L_XB = 147456;
constexpr int LDS_BYTES = 147712;
constexpr float C2 = 0.125f * 1.4426950408889634f;
#ifndef REP_P1
#define REP_P1 1
#endif
#ifndef REP_P2
#define REP_P2 1
#endif
#ifndef REP_P3
#define REP_P3 1
#endif
constexpr float NEGX = -1e30f, MINIT = -1e28f;

DI unsigned f2bf(float f) { unsigned u = __float_as_uint(f); return (u + 0x7fffu + ((u >> 16) & 1u)) >> 16; }
DI float bf2f(unsigned h) { return __uint_as_float(h << 16); }
DI unsigned cvtpk(float lo, float hi) { f32x2_t v = {lo, hi}; bf16x2_t b = __builtin_convertvector(v, bf16x2_t); return __builtin_bit_cast(unsigned, b); }
DI float ex2(float x) { return __builtin_amdgcn_exp2f(x); }
DI float wave_sum(float v) {
#pragma unroll
    for (int o = 1; o < 64; o <<= 1) v += __shfl_xor(v, o);
    return v;
}
DI float sigm_f(float z) { return __builtin_amdgcn_rcpf(1.f + ex2(-1.4426950408889634f * z)); }
DI float silu_f(float z) { return z * sigm_f(z); }
DI int crow(int i, int hi) { return (i & 3) + 8 * (i >> 2) + 4 * hi; }
DI s16x4 vtr(lds_cptr p) { return __builtin_bit_cast(s16x4, __builtin_amdgcn_ds_read_tr16_b64_v4i16((LAS v4i16_t*)p)); }
#define MFMA32(a, b, c) __builtin_amdgcn_mfma_f32_32x32x16_bf16((a), (b), (c), 0, 0, 0)
#define MFMA16(a, b, c) __builtin_amdgcn_mfma_f32_16x16x32_bf16((a), (b), (c), 0, 0, 0)

DI void kv_issue(const bf16* Kt, const bf16* Vt, int pitch, int wid, int lane, u32x4& kr, u32x4& vr) {
    kr = *(const u32x4*)(Kt + (size_t)lane * pitch + 8 * wid);
    vr = *(const u32x4*)(Vt + (size_t)(16 * (wid & 3) + (lane >> 2)) * pitch + (wid >> 2) * 32 + (lane & 3) * 8);
}
DI void kv_commit(char* buf, int tid, int wid, int lane, const u32x4& kr, const u32x4& vr, const u32x4& ar) {
    *(u32x4*)(buf + tid * 16) = kr;
    *(u32x4*)(buf + 9216 + tid * 16) = vr;
    if (wid == 0) *(u32x4*)(buf + 8192 + lane * 16) = ar;
}
DI void qk_tile(const char* kb, const bf16x8 (&qr)[5], int r32, int hi, f32x16& x0, f32x16& x1) {
    bf16x8 kf[10];
#pragma unroll
    for (int d0 = 0; d0 < 4; ++d0) {
        kf[2 * d0] = *(const bf16x8*)(kb + (2 * d0 + hi) * 1024 + r32 * 16);
        kf[2 * d0 + 1] = *(const bf16x8*)(kb + (2 * d0 + hi) * 1024 + 512 + r32 * 16);
    }
    kf[8] = *(const bf16x8*)(kb + 8192 + r32 * 16);
    kf[9] = *(const bf16x8*)(kb + 8192 + 512 + r32 * 16);
    asm volatile("s_waitcnt lgkmcnt(0)" ::: "memory");
#pragma unroll
    for (int i = 0; i < 16; ++i) { x0[i] = 0.f; x1[i] = 0.f; }
#pragma unroll
    for (int d0 = 0; d0 < 5; ++d0) { x0 = MFMA32(kf[2 * d0], qr[d0], x0); x1 = MFMA32(kf[2 * d0 + 1], qr[d0], x1); }
}
DI void v_load(const char* vb, int lane, int hi, bf16x8 (&vf)[8]) {
    const lds_cptr vp = (lds_cptr)vb + ((lane >> 4) & 1) * 32 + (lane & 3) * 8 + (4 * hi + ((lane & 15) >> 2)) * 64;
#pragma unroll
    for (int ks = 0; ks < 4; ++ks) {
        { const s16x4 lo = vtr(vp + ks * 1024), hh = vtr(vp + ks * 1024 + 512); vf[ks] = (bf16x8){lo[0], lo[1], lo[2], lo[3], hh[0], hh[1], hh[2], hh[3]}; }
        { const s16x4 lo = vtr(vp + 4096 + ks * 1024), hh = vtr(vp + 4096 + ks * 1024 + 512); vf[4 + ks] = (bf16x8){lo[0], lo[1], lo[2], lo[3], hh[0], hh[1], hh[2], hh[3]}; }
    }
    asm volatile("" ::: "memory");
}
DI void pv_tile(const bf16x8 (&vf)[8], const f32x16& p0, const f32x16& p1, f32x16& o0, f32x16& o1) {
    u32x4 w[4];
#pragma unroll
    for (int j = 0; j < 4; ++j) { w[0][j] = cvtpk(p0[2 * j], p0[2 * j + 1]); w[1][j] = cvtpk(p0[8 + 2 * j], p0[9 + 2 * j]);
                                  w[2][j] = cvtpk(p1[2 * j], p1[2 * j + 1]); w[3][j] = cvtpk(p1[8 + 2 * j], p1[9 + 2 * j]); }
#pragma unroll
    for (int ks = 0; ks < 4; ++ks) { const bf16x8 pb = __builtin_bit_cast(bf16x8, w[ks]); o0 = MFMA32(vf[ks], pb, o0); o1 = MFMA32(vf[4 + ks], pb, o1); }
}
DI void mask_tile(f32x16& x0, f32x16& x1, int klo, int khi, int hi) {
#pragma unroll
    for (int i = 0; i < 16; ++i) { const int k = crow(i, hi); if (k < klo || k > khi) x0[i] = NEGX; if (k + 32 < klo || k + 32 > khi) x1[i] = NEGX; }
}
DI float tile_max(const f32x16& x0, const f32x16& x1) {
    float ma = __builtin_fmaxf(x0[0], x1[0]), mb = __builtin_fmaxf(x0[1], x1[1]);
#pragma unroll
    for (int i = 2; i < 16; i += 2) { ma = __builtin_fmaxf(__builtin_fmaxf(ma, x0[i]), x1[i]); mb = __builtin_fmaxf(__builtin_fmaxf(mb, x0[i + 1]), x1[i + 1]); }
    const float mx = __builtin_fmaxf(ma, mb);
    return __builtin_fmaxf(mx, __shfl_xor(mx, 32));
}
DI void smx_tile(f32x16& x0, f32x16& x1, float& m, float& l, f32x16& o0, f32x16& o1) {
    const float mn = fmaxf(m, tile_max(x0, x1) * C2);
    const float al = ex2(m - mn); m = mn; l *= al;
    if (__any(al != 1.f)) {
#pragma unroll
        for (int i = 0; i < 16; ++i) { o0[i] *= al; o1[i] *= al; }
    }
    float s = 0.f;
#pragma unroll
    for (int i = 0; i < 16; ++i) { x0[i] = ex2(fmaf(x0[i], C2, -mn)); x1[i] = ex2(fmaf(x1[i], C2, -mn)); s += x0[i] + x1[i]; }
    l += s;
}
DI void smx_tile_sel(f32x16& x0, f32x16& x1, float& m, float& l, f32x16& o0, f32x16& o1, bool sel) {
    const float tm = tile_max(x0, x1) * C2;
    const float mn = sel ? fmaxf(m, tm) : m;
    const float al = ex2(m - mn); m = mn; l *= al;
    if (__any(al != 1.f)) {
#pragma unroll
        for (int i = 0; i < 16; ++i) { o0[i] *= al; o1[i] *= al; }
    }
    const float sub = sel ? mn : 3.0e38f;
    float s = 0.f;
#pragma unroll
    for (int i = 0; i < 16; ++i) { x0[i] = ex2(fmaf(x0[i], C2, -sub)); x1[i] = ex2(fmaf(x1[i], C2, -sub)); s += x0[i] + x1[i]; }
    l += s;
}
DI void smx_stats(const f32x16& x0, const f32x16& x1, float& m, float& l) {
    const float mn = fmaxf(m, tile_max(x0, x1) * C2);
    l *= ex2(m - mn); m = mn;
    float s = 0.f;
#pragma unroll
    for (int i = 0; i < 16; ++i) s += ex2(fmaf(x0[i], C2, -mn)) + ex2(fmaf(x1[i], C2, -mn));
    l += s;
}
DI void sb_tile(f32x16& x0, f32x16& x1, float& R, int hi) {
#pragma unroll
    for (int i = 0; i < 16; ++i) { x0[i] = __builtin_amdgcn_rcpf(1.f + ex2(x0[i] * C2)); x1[i] = __builtin_amdgcn_rcpf(1.f + ex2(x1[i] * C2)); }
    float qp[8], pq[8];
#pragma unroll
    for (int g = 0; g < 4; ++g) { qp[g] = (x0[4 * g] * x0[4 * g + 1]) * (x0[4 * g + 2] * x0[4 * g + 3]); qp[4 + g] = (x1[4 * g] * x1[4 * g + 1]) * (x1[4 * g + 2] * x1[4 * g + 3]); }
#pragma unroll
    for (int g = 0; g < 8; ++g) pq[g] = __shfl_xor(qp[g], 32);
    float Sfx = R;
#pragma unroll
    for (int gg = 7; gg >= 0; --gg) {
        float base = Sfx * (hi ? 1.f : pq[gg]);
        f32x16& x = (gg >= 4) ? x1 : x0; const int q4 = 4 * (gg & 3);
        const float r3 = x[q4 + 3], r2 = x[q4 + 2], r1 = x[q4 + 1], r0 = x[q4];
        x[q4 + 3] = fmaf(-r3, base, base); base *= r3;
        x[q4 + 2] = fmaf(-r2, base, base); base *= r2;
        x[q4 + 1] = fmaf(-r1, base, base); base *= r1;
        x[q4] = fmaf(-r0, base, base);
        Sfx *= qp[gg] * pq[gg];
    }
    R = Sfx;
}
DI void write_out(const f32x16& o0, const f32x16& o1, float sc, const bf16* zrow, bf16* orow, int hi) {
#pragma unroll
    for (int d0 = 0; d0 < 2; ++d0)
#pragma unroll
        for (int gq = 0; gq < 4; ++gq) {
            const int d = 32 * d0 + 8 * gq + 4 * hi;
            const u32x2 zz = *(const u32x2*)(zrow + d);
            const f32x16& o = d0 ? o1 : o0;
            const float v0 = o[4 * gq] * sc * silu_f(bf2f(zz.x & 0xffffu)), v1 = o[4 * gq + 1] * sc * silu_f(bf2f(zz.x >> 16));
            const float v2 = o[4 * gq + 2] * sc * silu_f(bf2f(zz.y & 0xffffu)), v3 = o[4 * gq + 3] * sc * silu_f(bf2f(zz.y >> 16));
            u32x2 w; w.x = cvtpk(v0, v1); w.y = cvtpk(v2, v3);
            *(u32x2*)(orow + d) = w;
        }
}
DI void write_out_t(const f32x16& o0, const f32x16& o1, float sc, const bf16* zrow0, size_t zpitch, bf16* orow0, size_t opitch, float* st, int lane) {
    const int q = lane & 31, hi = lane >> 5;
#pragma unroll
    for (int d0 = 0; d0 < 2; ++d0)
#pragma unroll
        for (int gq = 0; gq < 4; ++gq) {
            const int ch = 8 * d0 + 2 * gq + hi; const f32x16& o = d0 ? o1 : o0;
            *(f32x4*)(st + q * 64 + ((ch ^ (q & 15)) << 2)) = (f32x4){o[4 * gq] * sc, o[4 * gq + 1] * sc, o[4 * gq + 2] * sc, o[4 * gq + 3] * sc};
        }
#pragma unroll
    for (int j = 0; j < 4; ++j) {
        const int row = (lane >> 3) + 8 * j, c = lane & 7;
        const f32x4 a = *(const f32x4*)(st + row * 64 + (((2 * c) ^ (row & 15)) << 2)), b = *(const f32x4*)(st + row * 64 + (((2 * c + 1) ^ (row & 15)) << 2));
        const u32x4 zz = *(const u32x4*)(zrow0 + (size_t)row * zpitch + 8 * c);
        u32x4 w;
        w.x = cvtpk(a[0] * silu_f(bf2f(zz.x & 0xffffu)), a[1] * silu_f(bf2f(zz.x >> 16)));
        w.y = cvtpk(a[2] * silu_f(bf2f(zz.y & 0xffffu)), a[3] * silu_f(bf2f(zz.y >> 16)));
        w.z = cvtpk(b[0] * silu_f(bf2f(zz.z & 0xffffu)), b[1] * silu_f(bf2f(zz.z >> 16)));
        w.w = cvtpk(b[2] * silu_f(bf2f(zz.w & 0xffffu)), b[3] * silu_f(bf2f(zz.w >> 16)));
        *(u32x4*)(orow0 + (size_t)row * opitch + 8 * c) = w;
    }
}
DI void write_out_z(const f32x16& o0, const f32x16& o1, float sc, const u32x4 (&zpre)[4], bf16* orow0, size_t opitch, float* st, int lane) {
    const int q = lane & 31, hi = lane >> 5;
#pragma unroll
    for (int d0 = 0; d0 < 2; ++d0)
#pragma unroll
        for (int gq = 0; gq < 4; ++gq) {
            const int ch = 8 * d0 + 2 * gq + hi; const f32x16& o = d0 ? o1 : o0;
            *(f32x4*)(st + q * 64 + ((ch ^ (q & 15)) << 2)) = (f32x4){o[4 * gq] * sc, o[4 * gq + 1] * sc, o[4 * gq + 2] * sc, o[4 * gq + 3] * sc};
        }
#pragma unroll
    for (int j = 0; j < 4; ++j) {
        const int row = (lane >> 3) + 8 * j, c = lane & 7;
        const f32x4 a = *(const f32x4*)(st + row * 64 + (((2 * c) ^ (row & 15)) << 2)), b = *(const f32x4*)(st + row * 64 + (((2 * c + 1) ^ (row & 15)) << 2));
        const u32x4 zz = zpre[j];
        u32x4 w;
        w.x = cvtpk(a[0] * silu_f(bf2f(zz.x & 0xffffu)), a[1] * silu_f(bf2f(zz.x >> 16)));
        w.y = cvtpk(a[2] * silu_f(bf2f(zz.y & 0xffffu)), a[3] * silu_f(bf2f(zz.y >> 16)));
        w.z = cvtpk(b[0] * silu_f(bf2f(zz.z & 0xffffu)), b[1] * silu_f(bf2f(zz.z >> 16)));
        w.w = cvtpk(b[2] * silu_f(bf2f(zz.w & 0xffffu)), b[3] * silu_f(bf2f(zz.w >> 16)));
        *(u32x4*)(orow0 + (size_t)row * opitch + 8 * c) = w;
    }
}
DI void write_out_zh(const f32x16& o0, const f32x16& o1, float sc, const u32x4 (&zpre)[2], const bf16* zrow0, size_t zpitch, bf16* orow0, size_t opitch, float* st, int lane) {
    const int q = lane & 31, hi = lane >> 5;
#pragma unroll
    for (int d0 = 0; d0 < 2; ++d0)
#pragma unroll
        for (int gq = 0; gq < 4; ++gq) {
            const int ch = 8 * d0 + 2 * gq + hi; const f32x16& o = d0 ? o1 : o0;
            *(f32x4*)(st + q * 64 + ((ch ^ (q & 15)) << 2)) = (f32x4){o[4 * gq] * sc, o[4 * gq + 1] * sc, o[4 * gq + 2] * sc, o[4 * gq + 3] * sc};
        }
#pragma unroll
    for (int j = 0; j < 4; ++j) {
        const int row = (lane >> 3) + 8 * j, c = lane & 7;
        const f32x4 a = *(const f32x4*)(st + row * 64 + (((2 * c) ^ (row & 15)) << 2)), b = *(const f32x4*)(st + row * 64 + (((2 * c + 1) ^ (row & 15)) << 2));
        const u32x4 zz = j < 2 ? zpre[j & 1] : *(const u32x4*)(zrow0 + (size_t)row * zpitch + 8 * c);
        u32x4 w;
        w.x = cvtpk(a[0] * silu_f(bf2f(zz.x & 0xffffu)), a[1] * silu_f(bf2f(zz.x >> 16)));
        w.y = cvtpk(a[2] * silu_f(bf2f(zz.y & 0xffffu)), a[3] * silu_f(bf2f(zz.y >> 16)));
        w.z = cvtpk(b[0] * silu_f(bf2f(zz.z & 0xffffu)), b[1] * silu_f(bf2f(zz.z >> 16)));
        w.w = cvtpk(b[2] * silu_f(bf2f(zz.w & 0xffffu)), b[3] * silu_f(bf2f(zz.w >> 16)));
        *(u32x4*)(orow0 + (size_t)row * opitch + 8 * c) = w;
    }
}
DI u32x4 split3(float a) {
    const unsigned h = f2bf(a); const float r1 = a - bf2f(h); const unsigned m = f2bf(r1); const unsigned l = f2bf(r1 - bf2f(m));
    u32x4 r; r.x = h | (m << 16); r.y = l; r.z = 0u; r.w = 0u; return r;
}
DI u32x4 pos_aug(int pos) {
    u32x4 r; r.x = f2bf((float)(pos & ~7)) | (f2bf((float)(pos & 7)) << 16); r.y = 0u; r.z = 0u; r.w = 0u; return r;
}


DI void fox_unit(const bf16* PR, const float* AUX, const float* bfp, bf16* MIX, char* sm, int b, int h, int qb, bool do_cs) {
    int tid_ = threadIdx.x; asm volatile("" : "+v"(tid_)); const int tid = tid_, lane = tid & 63, r32 = lane & 31, hi = lane >> 5, wid = __builtin_amdgcn_readfirstlane(tid >> 6);
    float* cbuf = (float*)(sm + L_CBUF); float* miscf = (float*)(sm + L_MISC);
    const int nkeys = 256 * (qb + 1), q0 = 256 * qb; const size_t rb = (size_t)b * S;
    if (do_cs) {
        float v[4]; float run = 0.f; const float bias = bfp[h];
#pragma unroll
        for (int e = 0; e < 4; ++e) { const int s = 4 * tid + e; float ls = 0.f;
            if (s < nkeys) { const float x = AUX[(rb + s) * 32 + h] + bias; ls = fminf(x, 0.f) - 0.6931471805599453f * __builtin_amdgcn_logf(1.f + ex2(-1.4426950408889634f * fabsf(x))); }
            run += ls; v[e] = run; }
        float tot = run;
#pragma unroll
        for (int o = 1; o < 64; o <<= 1) { const float y = __shfl_up(tot, o); if (lane >= o) tot += y; }
        if (lane == 63) miscf[24 + wid] = tot;
        __syncthreads();
        float off = tot - run;
        for (int w = 0; w < wid; ++w) off += miscf[24 + w];
#pragma unroll
        for (int e = 0; e < 4; ++e) cbuf[4 * tid + e] = v[e] + off;
        __syncthreads();
    }
    const int t = q0 + 32 * wid + r32;
    bf16x8 qr[5];
#pragma unroll
    for (int d0 = 0; d0 < 4; ++d0) qr[d0] = *(const bf16x8*)(PR + (rb + t) * NP + C_FQ + 64 * h + 16 * d0 + 8 * hi);
    { const short one = hi ? (short)0 : (short)0x3F80; qr[4] = (bf16x8){one, one, one, 0, 0, 0, 0, 0}; }
    const float cref = cbuf[q0];
    const bf16* Kb = PR + rb * NP + C_FK + 64 * h; const bf16* Vb = PR + rb * NP + C_FV + 64 * h;
    float m = MINIT, l = 0.f; f32x16 o0, o1;
#pragma unroll
    for (int i = 0; i < 16; ++i) { o0[i] = 0.f; o1[i] = 0.f; }
    unsigned z_ = 0u; asm volatile("" : "+v"(z_)); u32x4 kr, vr, ar = {z_, z_, z_, z_};
    const int wq0 = q0 + 32 * wid;
    u32x4 zpre[4];
    const bf16* zrow0 = PR + (rb + wq0) * NP + C_FZ + 64 * h;
    float q1 = 0.f;
#pragma unroll
    for (int d0 = 0; d0 < 4; ++d0)
#pragma unroll
        for (int j = 0; j < 8; ++j) q1 += fabsf(bf2f((unsigned)(unsigned short)qr[d0][j]));
    q1 += __shfl_xor(q1, 32);
    volatile LAS unsigned* kmx = (volatile LAS unsigned*)(sm + L_MISC) + 32;
    for (int it_ = -1, nt_ = (4 * qb + 4); it_ < nt_; ++it_) {
        const bool more_ = it_ + 1 < nt_;
        if (!more_) {
#pragma unroll
            for (int j = 0; j < 4; ++j) zpre[j] = *(const u32x4*)(zrow0 + (size_t)((lane >> 3) + 8 * j) * NP + 8 * (lane & 7));
        }
        if (more_) { const int kt = nt_ - 2 - it_; { kv_issue(Kb + (size_t)(64 * kt) * NP, Vb + (size_t)(64 * kt) * NP, NP, wid, lane, kr, vr);
          if (wid == 0) ar = split3(8.f * (cref - cbuf[64 * kt + lane])); } }
        if (it_ >= 0) { const int kt = nt_ - 1 - it_; const char* cb = sm + (it_ & 1) * STG; { if (64 * kt <= wq0 + 31) {
              unsigned kb_ = 0u;
#pragma unroll
              for (int w = 0; w < 8; ++w) { const unsigned v_ = kmx[(it_ & 1) * 8 + w]; kb_ = v_ > kb_ ? v_ : kb_; }
              const float ub = C2 * (q1 * bf2f(kb_) + 8.f * (cref - cbuf[64 * kt + 63]));
              if (!__all(ub - m < -160.f)) {
                  f32x16 x0, x1; qk_tile(cb, qr, r32, hi, x0, x1); bf16x8 vf[8]; v_load(cb + 9216, lane, hi, vf);
                  if (64 * kt + 63 > wq0) mask_tile(x0, x1, 0, t - 64 * kt, hi);
                  smx_tile(x0, x1, m, l, o0, o1);
                  pv_tile(vf, x0, x1, o0, o1); } } } }
        if (more_) { kv_commit(sm + ((it_ + 1) & 1) * STG, tid, wid, lane, kr, vr, ar);
            unsigned mk = (kr.x & 0x7fffu); { const unsigned t1 = (kr.x >> 16) & 0x7fffu; mk = t1 > mk ? t1 : mk; }
            { const unsigned t0 = kr.y & 0x7fffu, t1 = (kr.y >> 16) & 0x7fffu; mk = t0 > mk ? t0 : mk; mk = t1 > mk ? t1 : mk; }
            { const unsigned t0 = kr.z & 0x7fffu, t1 = (kr.z >> 16) & 0x7fffu; mk = t0 > mk ? t0 : mk; mk = t1 > mk ? t1 : mk; }
            { const unsigned t0 = kr.w & 0x7fffu, t1 = (kr.w >> 16) & 0x7fffu; mk = t0 > mk ? t0 : mk; mk = t1 > mk ? t1 : mk; }
#pragma unroll
            for (int o = 1; o < 64; o <<= 1) { const unsigned y = (unsigned)__shfl_xor((int)mk, o); mk = y > mk ? y : mk; }
            if (lane == 0) kmx[((it_ + 1) & 1) * 8 + wid] = mk; }
        __syncthreads();
    }

    const float lt = l + __shfl_xor(l, 32);
    write_out_z(o0, o1, lt > 0.f ? 1.f / lt : 0.f, zpre, MIX + (rb + wq0) * D + 64 * h, D, (float*)(sm + L_TACC) + wid * 2048, lane);
}

DI void sb_unit(const bf16* PR, bf16* MIX, char* sm, int b, int h, int qb) {
    int tid_ = threadIdx.x; asm volatile("" : "+v"(tid_)); const int tid = tid_, lane = tid & 63, r32 = lane & 31, hi = lane >> 5, wid = __builtin_amdgcn_readfirstlane(tid >> 6);
    volatile LAS unsigned* misc = (volatile LAS unsigned*)(sm + L_MISC);
    const int q0 = 256 * qb; const size_t rb = (size_t)b * S;
    const int t = q0 + 32 * wid + r32, wq0 = q0 + 32 * wid;
    bf16x8 qr[5];
#pragma unroll
    for (int d0 = 0; d0 < 4; ++d0) qr[d0] = *(const bf16x8*)(PR + (rb + t) * NP + C_SQ + 64 * h + 16 * d0 + 8 * hi);
    qr[4] = (bf16x8){0, 0, 0, 0, 0, 0, 0, 0};
    const bf16* Kb = PR + rb * NP + C_SK + 64 * h; const bf16* Vb = PR + rb * NP + C_SV + 64 * h;
    float R = 1.f; f32x16 o0, o1;
#pragma unroll
    for (int i = 0; i < 16; ++i) { o0[i] = 0.f; o1[i] = 0.f; }
    unsigned z_ = 0u; asm volatile("" : "+v"(z_)); u32x4 kr, vr, ar = {z_, z_, z_, z_};
    const int nt = 4 * qb + 4;
    u32x4 zpre[4];
    { const bf16* zrow0 = PR + (rb + wq0) * NP + C_SZ + 64 * h;
#pragma unroll
      for (int j = 0; j < 4; ++j) zpre[j] = *(const u32x4*)(zrow0 + (size_t)((lane >> 3) + 8 * j) * NP + 8 * (lane & 7)); }
    { const int kt = nt - 1; kv_issue(Kb + (size_t)(64 * kt) * NP, Vb + (size_t)(64 * kt) * NP, NP, wid, lane, kr, vr); }
    kv_commit(sm, tid, wid, lane, kr, vr, ar); __syncthreads();
    for (int it = 0; it < nt; ++it) {
        const int kt = nt - 1 - it; const char* cb = sm + (it & 1) * STG; const bool more = it + 1 < nt;
        if (more) kv_issue(Kb + (size_t)(64 * (kt - 1)) * NP, Vb + (size_t)(64 * (kt - 1)) * NP, NP, wid, lane, kr, vr);
        bool wdone = false;
        if (64 * kt <= wq0 + 30) {
            if (__any(R >= 1e-30f)) {
                f32x16 x0, x1; qk_tile(cb, qr, r32, hi, x0, x1); bf16x8 vf[8]; v_load(cb + 9216, lane, hi, vf);
                if (64 * kt + 63 >= wq0) mask_tile(x0, x1, 0, t - 1 - 64 * kt, hi);
                sb_tile(x0, x1, R, hi);
                pv_tile(vf, x0, x1, o0, o1);
            }
            wdone = !__any(R >= 1e-30f);
        }
        if (lane == 0) misc[2 + (it & 1) * 8 + wid] = wdone ? 1u : 0u;
        if (more) kv_commit(sm + ((it + 1) & 1) * STG, tid, wid, lane, kr, vr, ar);
        __syncthreads();
        unsigned alld = 1u;
#pragma unroll
        for (int w = 0; w < 8; ++w) alld &= misc[2 + (it & 1) * 8 + w];
        if (alld) break;
    }
    __syncthreads();
    write_out_z(o0, o1, 1.f, zpre, MIX + (rb + wq0) * D + 384 + 64 * h, D, (float*)(sm + L_TACC) + wid * 2048, lane);
}

DI void cmp_unit(const bf16* PR, const bf16* W1T, const bf16* W2T, const float* PB, bf16* OUT, int col, char* sm, int b, int ntile) {
    int tid_ = threadIdx.x; asm volatile("" : "+v"(tid_)); const int tid = tid_, lane = tid & 63, wid = __builtin_amdgcn_readfirstlane(tid >> 6);
    float* red = (float*)(sm + L_RED); float* hid = (float*)(sm + L_HID);
    const int row = lane & 15, kq = lane >> 4;
    const int n = 16 * ntile + row, nc = n < 126 ? n : 126;
    f32x4 acc[4];
#pragma unroll
    for (int e = 0; e < 4; ++e) acc[e] = (f32x4){0.f, 0.f, 0.f, 0.f};
#pragma unroll
    for (int half = 0; half < 2; ++half) {
        bf16x8 af[4], bfr[4][4];
#pragma unroll
        for (int s4 = 0; s4 < 4; ++s4) {
            const int f0 = 256 * wid + 32 * (4 * half + s4) + 8 * kq, tl = f0 >> 6, d = f0 & 63;
            af[s4] = *(const bf16x8*)(PR + ((size_t)b * S + 16 * nc + tl) * NP + col + d);
#pragma unroll
            for (int et = 0; et < 4; ++et) bfr[s4][et] = *(const bf16x8*)(W1T + (size_t)(16 * et + row) * 2048 + f0);
        }
#pragma unroll
        for (int s4 = 0; s4 < 4; ++s4)
#pragma unroll
            for (int et = 0; et < 4; ++et) acc[et] = MFMA16(af[s4], bfr[s4][et], acc[et]);
    }
#pragma unroll
    for (int et = 0; et < 4; ++et)
#pragma unroll
        for (int j = 0; j < 4; ++j) red[(wid * 16 + kq * 4 + j) * 64 + 16 * et + row] = acc[et][j];
    __syncthreads();
    for (int idx = tid; idx < 1024; idx += 512) { float s = 0.f;
#pragma unroll
        for (int w = 0; w < 8; ++w) s += red[w * 1024 + idx];
        s += PB[idx & 63]; hid[idx] = silu_f(s); }
    __syncthreads();
    if (wid < 4) {
        f32x4 c = (f32x4){0.f, 0.f, 0.f, 0.f};
#pragma unroll
        for (int step = 0; step < 2; ++step) {
            const float* hp = hid + row * 64 + 32 * step + 8 * kq;
            u32x4 aw; aw.x = cvtpk(hp[0], hp[1]); aw.y = cvtpk(hp[2], hp[3]); aw.z = cvtpk(hp[4], hp[5]); aw.w = cvtpk(hp[6], hp[7]);
            const bf16x8 bb = *(const bf16x8*)(W2T + (size_t)(16 * wid + row) * 64 + 32 * step + 8 * kq);
            c = MFMA16(__builtin_bit_cast(bf16x8, aw), bb, c);
        }
#pragma unroll
        for (int j = 0; j < 4; ++j) { const int nn = 16 * ntile + kq * 4 + j; OUT[((size_t)b * 128 + nn) * 64 + 16 * wid + row] = (bf16)(nn <= 126 ? f2bf(c[j]) : 0u); }
    }
    __syncthreads();
}

DI int nth_set_desc(unsigned m, int n) { for (int i = 0; i < n; ++i) m &= ~(1u << (31 - __clz((int)m))); return 31 - __clz((int)m); }
DI int nth_set(unsigned m, int n) { for (int i = 0; i < n; ++i) m &= m - 1u; return __ffs((int)m) - 1; }
DI void nsa_unit(const bf16* PR, const float* AUX, const bf16* KC, const bf16* VC, bf16* MIX, char* sm, int b, int qb) {
    int tid_ = threadIdx.x; asm volatile("" : "+v"(tid_)); const int tid = tid_, lane = tid & 63, r32 = lane & 31, hi = lane >> 5, wid = __builtin_amdgcn_readfirstlane(tid >> 6);
    float* impL = (float*)(sm + L_IMP); volatile LAS unsigned* selm = (volatile LAS unsigned*)(sm + L_SELM); volatile LAS unsigned* misc = (volatile LAS unsigned*)(sm + L_MISC);
    const int g = wid >> 1, ql = 32 * (wid & 1) + r32, cur = qb, t = 64 * qb + ql; const size_t rb = (size_t)b * S, row = rb + t;
    bf16x8 qr[5];
#pragma unroll
    for (int d0 = 0; d0 < 4; ++d0) qr[d0] = *(const bf16x8*)(PR + row * NP + C_NQ + 64 * g + 16 * d0 + 8 * hi);
    { const short s8 = hi ? (short)0 : (short)f2bf(exp2f((float)(1 - 2 * g))); qr[4] = (bf16x8){s8, s8, 0, 0, 0, 0, 0, 0}; }
    const float g0 = sigm_f(AUX[row * 32 + 6 + 3 * g]), g1 = sigm_f(AUX[row * 32 + 7 + 3 * g]), g2 = sigm_f(AUX[row * 32 + 8 + 3 * g]);
    f32x16 o0, o1;
    float* tacc = (float*)(sm + L_TACC) + wid * 2048 + lane;
    unsigned z_ = 0u; asm volatile("" : "+v"(z_)); u32x4 kr, vr, ar = {z_, z_, z_, z_};
    const int ntc = (4 * qb + 2) / 64 + 1, khc = (t - 31) >> 4;
    const bf16* KCb = KC + (size_t)b * 128 * 64; const bf16* VCb = VC + (size_t)b * 128 * 64;
    float m = MINIT, l = 0.f;
    {
        u32x4 kr2, vr2, ar2;
        kv_issue(KCb, VCb, 64, wid, lane, kr, vr); if (wid == 0) ar = pos_aug(16 * lane + 31);
        if (ntc > 1) { kv_issue(KCb + 64 * 64, VCb + 64 * 64, 64, wid, lane, kr2, vr2); if (wid == 0) ar2 = pos_aug(16 * (64 + lane) + 31); }
        kv_commit(sm, tid, wid, lane, kr, vr, ar);
        if (ntc > 1) kv_commit(sm + STG, tid, wid, lane, kr2, vr2, ar2);
        __syncthreads();
        for (int it = 0; it < ntc; ++it) { const char* cb = sm + it * STG; f32x16 x0, x1; qk_tile(cb, qr, r32, hi, x0, x1); mask_tile(x0, x1, 0, khc - 64 * it, hi); smx_stats(x0, x1, m, l); }
        const float lt = l + __shfl_xor(l, 32); const float invl = lt > 0.f ? 1.f / lt : 0.f;
        float carry = 0.f;
#pragma unroll
        for (int i = 0; i < 16; ++i) { o0[i] = 0.f; o1[i] = 0.f; }
        for (int it = 0; it < ntc; ++it) { const char* cb = sm + it * STG;
              f32x16 x0, x1; qk_tile(cb, qr, r32, hi, x0, x1); bf16x8 vf[8]; v_load(cb + 9216, lane, hi, vf); mask_tile(x0, x1, 0, khc - 64 * it, hi);
#pragma unroll
              for (int i = 0; i < 16; ++i) { x0[i] = ex2(fmaf(x0[i], C2, -m)) * invl; x1[i] = ex2(fmaf(x1[i], C2, -m)) * invl; }
              float qs[8], lastv[8], rcv[8];
#pragma unroll
              for (int gq = 0; gq < 4; ++gq) { qs[gq] = (x0[4 * gq] + x0[4 * gq + 1]) + (x0[4 * gq + 2] + x0[4 * gq + 3]); lastv[gq] = x0[4 * gq + 3];
                                               qs[4 + gq] = (x1[4 * gq] + x1[4 * gq + 1]) + (x1[4 * gq + 2] + x1[4 * gq + 3]); lastv[4 + gq] = x1[4 * gq + 3]; }
#pragma unroll
              for (int gq = 0; gq < 8; ++gq) rcv[gq] = __shfl_xor(lastv[gq], 32);
#pragma unroll
              for (int gq = 0; gq < 8; ++gq) {
                  const float add0 = gq > 0 ? rcv[gq - 1] : carry;
                  const float val = qs[gq] + (hi ? rcv[gq] : add0);
                  impL[(g * 64 + ql) * 33 + 16 * it + 2 * gq + hi] = val;
              }
              carry = rcv[7];
              pv_tile(vf, x0, x1, o0, o1); }
        __syncthreads();
#pragma unroll
        for (int i = 0; i < 16; ++i) { tacc[i * 64] = g0 * o0[i]; tacc[(16 + i) * 64] = g0 * o1[i]; }
    }
    if (wid == 0) {
        const unsigned forced = 1u | (1u << cur) | (cur >= 1 ? (1u << (cur - 1)) : 0u);
        unsigned selbits = forced; const int ncand = cur - 2;
        if (ncand > 0) {
            const int nfree = 8 - __popc(forced);
            if (ncand <= nfree) selbits |= ((1u << (cur - 1)) - 2u);
            else {
                float* rowp = impL + lane * 33;
                for (int j = 1; j <= cur - 2; ++j) rowp[j] = ((rowp[j] + impL[(64 + lane) * 33 + j]) + impL[(128 + lane) * 33 + j]) + impL[(192 + lane) * 33 + j];
                for (int r = 0; r < nfree; ++r) { float best = -1.f; int bj = 1;
                    for (int j = 1; j <= cur - 2; ++j) { const float v = rowp[j]; if (v > best) { best = v; bj = j; } }
                    selbits |= 1u << bj; rowp[bj] = -2.f; }
            }
        }
        selm[lane] = selbits;
        unsigned any = selbits;
#pragma unroll
        for (int o = 1; o < 64; o <<= 1) any |= (unsigned)__shfl_xor((int)any, o);
        if (lane == 0) misc[1] = any;
    }
    __syncthreads();
    {
        const unsigned anym = misc[1] & ((2u << cur) - 1u); const unsigned mysel = selm[ql];
        const int nts = __popc(anym);
        const bf16* Kb = PR + rb * NP + C_NKS; const bf16* Vb = PR + rb * NP + C_NVS;
        m = MINIT; l = 0.f;
#pragma unroll
        for (int i = 0; i < 16; ++i) { o0[i] = 0.f; o1[i] = 0.f; }
        for (int it_ = -1, nt_ = (nts); it_ < nt_; ++it_) {
        const bool more_ = it_ + 1 < nt_;
        if (more_) { const int it = it_ + 1; { const int j = nth_set_desc(anym, it); kv_issue(Kb + (size_t)(64 * j) * NP, Vb + (size_t)(64 * j) * NP, NP, wid, lane, kr, vr); if (wid == 0) ar = pos_aug(64 * j + lane); } }
        if (it_ >= 0) { const int it = it_; const char* cb = sm + (it & 1) * STG; { const int j = nth_set_desc(anym, it);
              f32x16 x0, x1; qk_tile(cb, qr, r32, hi, x0, x1); bf16x8 vf[8]; v_load(cb + 9216, lane, hi, vf);
              const bool selj = ((mysel >> j) & 1u) != 0u;
              if (j == cur) mask_tile(x0, x1, 0, selj ? t - 64 * j : -1, hi);
              smx_tile_sel(x0, x1, m, l, o0, o1, selj || j == cur);
              pv_tile(vf, x0, x1, o0, o1); } }
        if (more_) kv_commit(sm + ((it_ + 1) & 1) * STG, tid, wid, lane, kr, vr, ar);
        __syncthreads();
    }

        const float lt = l + __shfl_xor(l, 32); const float sc = lt > 0.f ? g1 / lt : 0.f;
#pragma unroll
        for (int i = 0; i < 16; ++i) { tacc[i * 64] += sc * o0[i]; tacc[(16 + i) * 64] += sc * o1[i]; }
    }
    u32x4 zpre[2];
    {
        const int j0 = cur >= 8 ? cur - 8 : 0;
        const bf16* Kb = PR + rb * NP + C_NKW; const bf16* Vb = PR + rb * NP + C_NVW;
        m = MINIT; l = 0.f;
#pragma unroll
        for (int i = 0; i < 16; ++i) { o0[i] = 0.f; o1[i] = 0.f; }
        for (int it_ = -1, nt_ = (cur - j0 + 1); it_ < nt_; ++it_) {
        const bool more_ = it_ + 1 < nt_;
        if (!more_) { const bf16* zrow0 = PR + (rb + 64 * qb + 32 * (wid & 1)) * NP + C_NZ + 64 * g;
#pragma unroll
            for (int j = 0; j < 2; ++j) zpre[j] = *(const u32x4*)(zrow0 + (size_t)((lane >> 3) + 8 * j) * NP + 8 * (lane & 7)); }
        if (more_) { const int it = it_ + 1; { const int j = cur - it; kv_issue(Kb + (size_t)(64 * j) * NP, Vb + (size_t)(64 * j) * NP, NP, wid, lane, kr, vr); if (wid == 0) ar = pos_aug(64 * j + lane); } }
        if (it_ >= 0) { const int it = it_; const char* cb = sm + (it & 1) * STG; { const int j = cur - it;
              f32x16 x0, x1; qk_tile(cb, qr, r32, hi, x0, x1); bf16x8 vf[8]; v_load(cb + 9216, lane, hi, vf);
              if (j == cur || j == cur - 8) mask_tile(x0, x1, t - 511 - 64 * j, t - 64 * j, hi);
              smx_tile(x0, x1, m, l, o0, o1);
              pv_tile(vf, x0, x1, o0, o1); } }
        if (more_) kv_commit(sm + ((it_ + 1) & 1) * STG, tid, wid, lane, kr, vr, ar);
        __syncthreads();
    }

        const float lt = l + __shfl_xor(l, 32); const float sc = lt > 0.f ? g2 / lt : 0.f;
#pragma unroll
        for (int i = 0; i < 16; ++i) { o0[i] = tacc[i * 64] + sc * o0[i]; o1[i] = tacc[(16 + i) * 64] + sc * o1[i]; }
    }
    { const size_t r0 = rb + 64 * qb + 32 * (wid & 1);
      write_out_zh(o0, o1, 1.f, zpre, PR + r0 * NP + C_NZ + 64 * g, NP, MIX + r0 * D + 768 + 64 * g, D, (float*)(sm + L_TACC) + wid * 2048, lane); }
}

struct EpiProj {
    static constexpr bool PERM = true, AFTER_DRAIN = false;
    bf16* O; float* aux;
    __device__ __forceinline__ void operator()(const f32x4 (&acc)[2][2][4][2], const pg8::Unit& u, int wr, int wc, int fr, int fq) const {
        const int row0 = u.pm * 256 + wr * 64 + fr, col0 = u.pn * 256 + wc * 32 + 8 * fq;
#pragma unroll
        for (int ai = 0; ai < 2; ++ai)
#pragma unroll
            for (int m = 0; m < 4; ++m) { bf16* rowp = O + (size_t)(row0 + ai * 128 + m * 16) * NP + col0;
#pragma unroll
                for (int bj = 0; bj < 2; ++bj) { const f32x4 v0 = acc[ai][bj][m][0], v1 = acc[ai][bj][m][1];
                    u32x4 w; w.x = cvtpk(v0[0], v0[1]); w.y = cvtpk(v0[2], v0[3]); w.z = cvtpk(v1[0], v1[1]); w.w = cvtpk(v1[2], v1[3]);
                    *(u32x4*)(rowp + bj * 128) = w; } }
        if (u.pn == 15 && wc == 0) {
#pragma unroll
            for (int ai = 0; ai < 2; ++ai)
#pragma unroll
                for (int m = 0; m < 4; ++m) { float* ap = aux + (size_t)(row0 + ai * 128 + m * 16) * 32 + 8 * fq;
                    *(f32x4*)ap = acc[ai][1][m][0]; *(f32x4*)(ap + 4) = acc[ai][1][m][1]; }
        }
    }
};
struct EpiOut {
    static constexpr bool PERM = true, AFTER_DRAIN = false;
    const float* X; float* O;
    __device__ __forceinline__ void operator()(const f32x4 (&acc)[2][2][4][2], const pg8::Unit& u, int wr, int wc, int fr, int fq) const {
        const int row0 = u.pm * 256 + wr * 64 + fr, col0 = u.pn * 256 + wc * 32 + 8 * fq;
#pragma unroll
        for (int ai = 0; ai < 2; ++ai)
#pragma unroll
            for (int m = 0; m < 4; ++m)
#pragma unroll
                for (int bj = 0; bj < 2; ++bj) { const size_t idx = (size_t)(row0 + ai * 128 + m * 16) * D + col0 + bj * 128;
                    const f32x4 a = *(const f32x4*)(X + idx), c = *(const f32x4*)(X + idx + 4);
                    *(f32x4*)(O + idx) = a + acc[ai][bj][m][0]; *(f32x4*)(O + idx + 4) = c + acc[ai][bj][m][1]; }
    }
};

DI int src_col(int np) {
    if (np < 1152) return np;
    if (np < 3712) return np + 6;
    if (np < 3968) return np + 18;
    if (np < 3974) return 1152 + (np - 3968);
    if (np < 3986) return 3718 + (np - 3974);
    return -1;
}
DI void transpose_item(const float* W, int K, int N, bf16* WT, int nblk, bool perm, float* scr, int item, int lane) {
    const int kb = item / nblk, nb = item % nblk, k0 = 64 * kb, n0 = 32 * nb;
    const int np = n0 + (lane & 31); const int sc = perm ? src_col(np) : np;
    float wv[32];
#pragma unroll
    for (int i = 0; i < 32; ++i) { const int kk = 2 * i + (lane >> 5); wv[i] = sc >= 0 ? W[(size_t)(k0 + kk) * N + sc] : 0.f; }
#pragma unroll
    for (int i = 0; i < 32; ++i) { const int kk = 2 * i + (lane >> 5); scr[kk * 33 + (lane & 31)] = wv[i]; }
    __builtin_amdgcn_s_waitcnt(0); __builtin_amdgcn_wave_barrier();
    const int c = lane & 7;
#pragma unroll
    for (int j = 0; j < 4; ++j) { const int n = (lane >> 3) + 8 * j; const float* s = scr + (8 * c) * 33 + n;
        u32x4 o; o.x = cvtpk(s[0 * 33], s[1 * 33]); o.y = cvtpk(s[2 * 33], s[3 * 33]); o.z = cvtpk(s[4 * 33], s[5 * 33]); o.w = cvtpk(s[6 * 33], s[7 * 33]);
        *(u32x4*)(WT + (size_t)(n0 + n) * K + k0 + 8 * c) = o; }
    __builtin_amdgcn_s_waitcnt(0); __builtin_amdgcn_wave_barrier();
}
DI void norm_row_bf16(const float* xrow, const float* gw, bf16* orow, int lane) {
    f32x4 v[4]; float s = 0.f;
#pragma unroll
    for (int j = 0; j < 4; ++j) { v[j] = *(const f32x4*)(xrow + 4 * lane + 256 * j); s += (v[j].x * v[j].x + v[j].y * v[j].y) + (v[j].z * v[j].z + v[j].w * v[j].w); }
    const float rs = 1.f / sqrtf(wave_sum(s) * (1.f / D) + 1e-6f);
#pragma unroll
    for (int j = 0; j < 4; ++j) { const f32x4 gg = *(const f32x4*)(gw + 4 * lane + 256 * j);
        u32x2 w; w.x = cvtpk(v[j].x * rs * gg.x, v[j].y * rs * gg.y); w.y = cvtpk(v[j].z * rs * gg.z, v[j].w * rs * gg.w);
        *(u32x2*)(orow + 4 * lane + 256 * j) = w; }
}
DI void norm_row_f32(float* xrow, const float* gw, int lane) {
    f32x4 v[4]; float s = 0.f;
#pragma unroll
    for (int j = 0; j < 4; ++j) { v[j] = *(const f32x4*)(xrow + 4 * lane + 256 * j); s += (v[j].x * v[j].x + v[j].y * v[j].y) + (v[j].z * v[j].z + v[j].w * v[j].w); }
    const float rs = 1.f / sqrtf(wave_sum(s) * (1.f / D) + 1e-6f);
#pragma unroll
    for (int j = 0; j < 4; ++j) { const f32x4 gg = *(const f32x4*)(gw + 4 * lane + 256 * j);
        *(f32x4*)(xrow + 4 * lane + 256 * j) = (f32x4){v[j].x * rs * gg.x, v[j].y * rs * gg.y, v[j].z * rs * gg.z, v[j].w * rs * gg.w}; }
}

template <bool BF> DI void norm_rows4(float* src, const float* gw, bf16* dstb, int r0, int stride, int lane) {
    f32x4 v[4][4];
#pragma unroll
    for (int k = 0; k < 4; ++k) { const int r = r0 + k * stride;
#pragma unroll
        for (int j = 0; j < 4; ++j) v[k][j] = r < M ? *(const f32x4*)(src + (size_t)r * D + 4 * lane + 256 * j) : (f32x4){0.f, 0.f, 0.f, 0.f}; }
    f32x4 gg[4];
#pragma unroll
    for (int j = 0; j < 4; ++j) gg[j] = *(const f32x4*)(gw + 4 * lane + 256 * j);
#pragma unroll
    for (int k = 0; k < 4; ++k) { const int r = r0 + k * stride; float s = 0.f;
#pragma unroll
        for (int j = 0; j < 4; ++j) s += (v[k][j].x * v[k][j].x + v[k][j].y * v[k][j].y) + (v[k][j].z * v[k][j].z + v[k][j].w * v[k][j].w);
        const float rs = 1.f / sqrtf(wave_sum(s) * (1.f / D) + 1e-6f);
        if (r < M) {
#pragma unroll
            for (int j = 0; j < 4; ++j) {
                const f32x4 y = (f32x4){v[k][j].x * rs * gg[j].x, v[k][j].y * rs * gg[j].y, v[k][j].z * rs * gg[j].z, v[k][j].w * rs * gg[j].w};
                if (BF) { u32x2 w; w.x = cvtpk(y.x, y.y); w.y = cvtpk(y.z, y.w); *(u32x2*)(dstb + (size_t)r * D + 4 * lane + 256 * j) = w; }
                else __builtin_nontemporal_store(y, (f32x4*)(src + (size_t)r * D + 4 * lane + 256 * j));
            }
        }
    }
}

struct Params { const float *x, *norm_g, *w_in, *b_f, *pos_k, *w1_k, *w2_k, *pos_v, *w1_v, *w2_v, *w_out, *final_g; float* out; unsigned char* ws; };

DI int next_unit(unsigned* ctr, char* sm) {
    volatile LAS int* slot = (volatile LAS int*)(sm + L_MISC);
    __syncthreads();
    if (threadIdx.x == 0) *slot = (int)atomicAdd(ctr, 1u);
    __syncthreads();
    return *slot;
}

#define XB_TMO      128
#define XB_XCNT(j)  (256  + 64 * (j))
#define XB_XSUB(j)  (1280 + 64 * (j))
#define XB_XGEN(j)  (2304 + 64 * (j))
#define XB_TOP      3328
#define XB_TOPGEN   3392
#define XCD_BAR_WORDS 3456
#define XB_SPIN_CAP (1u << 18)

__device__ __forceinline__ unsigned xb_ld(unsigned* p)              { return __hip_atomic_load(p, __ATOMIC_RELAXED, __HIP_MEMORY_SCOPE_AGENT); }
__device__ __forceinline__ unsigned xb_add(unsigned* p, unsigned v) { return __hip_atomic_fetch_add(p, v, __ATOMIC_RELAXED, __HIP_MEMORY_SCOPE_AGENT); }
__device__ __forceinline__ unsigned xb_xcc_id() { return (unsigned)__builtin_amdgcn_s_getreg((3 << 11) | 20) & 0xFu; }
#define XB_SPIN(cond, bar) do { unsigned _sp = 0; while (cond) { __builtin_amdgcn_s_sleep(1); \
    if ((++_sp & 255u) == 0u) { if (xb_ld(&(bar)[XB_TMO])) break; if (_sp > XB_SPIN_CAP) { atomicAdd(&(bar)[XB_TMO], 1u); break; } } } } while (0)

struct XcdBarrier {
    unsigned* bar; unsigned x;
    volatile LAS unsigned* st;
};

__device__ __forceinline__ XcdBarrier xcd_barrier_post(unsigned* bar, volatile LAS unsigned* st) {
    XcdBarrier b; b.bar = bar; b.x = xb_xcc_id(); b.st = st;
    if (threadIdx.x == 0) (void)xb_add(&bar[XB_XCNT(b.x)], 1u);
    return b;
}
__device__ __forceinline__ void xcd_barrier_complete(unsigned* bar, unsigned x, unsigned& nloc, unsigned& nx) {
    const unsigned G = gridDim.x * gridDim.y * gridDim.z;
    unsigned sum, cnt, mine, sp = 0u;
    for (;;) {
        sum = 0u; cnt = 0u; mine = 0u;
#pragma unroll
        for (unsigned j = 0; j < 16; ++j) { const unsigned c = xb_ld(&bar[XB_XCNT(j)]); sum += c; cnt += (c > 0u) ? 1u : 0u; mine = (j == x) ? c : mine; }
        if (sum == G) break;
        __builtin_amdgcn_s_sleep(1);
        if ((++sp & 255u) == 0u) { if (xb_ld(&bar[XB_TMO])) break; if (sp > XB_SPIN_CAP) { atomicAdd(&bar[XB_TMO], 1u); break; } }
    }
    nloc = mine > 0u ? mine : 1u; nx = cnt > 0u ? cnt : 1u;
}

__device__ __forceinline__ void xcd_barrier(const XcdBarrier& b) {
    asm volatile("s_waitcnt vmcnt(0)" ::: "memory");
    __syncthreads();
    if (threadIdx.x == 0) {
        unsigned* bar = b.bar;
        __builtin_amdgcn_s_waitcnt(0);
        unsigned nloc = b.st[0], nx = b.st[1];
        if (nloc == 0u) { xcd_barrier_complete(bar, b.x, nloc, nx); b.st[0] = nloc; b.st[1] = nx; }
        const unsigned old = xb_add(&bar[XB_XSUB(b.x)], 1u);
        const unsigned gen = old / nloc;
        if (old + 1u == (gen + 1u) * nloc) {
            __builtin_amdgcn_fence(__ATOMIC_RELEASE, "agent");
            asm volatile("s_waitcnt vmcnt(0)" ::: "memory");
            const unsigned og = xb_add(&bar[XB_TOP], 1u);
            const unsigned tg = og / nx;
            if (og + 1u == (tg + 1u) * nx) xb_add(&bar[XB_TOPGEN], 1u);
            else XB_SPIN(xb_ld(&bar[XB_TOPGEN]) == tg, bar);
            __builtin_amdgcn_fence(__ATOMIC_ACQUIRE, "agent");
            xb_add(&bar[XB_XGEN(b.x)], 1u);
            asm volatile("s_waitcnt vmcnt(0)" ::: "memory");
        } else {
            XB_SPIN(xb_ld(&bar[XB_XGEN(b.x)]) == gen, bar);
            __builtin_amdgcn_fence(__ATOMIC_ACQUIRE, "agent");
            asm volatile("s_waitcnt vmcnt(0)" ::: "memory");
        }
    }
    __syncthreads();
}

__global__ void __launch_bounds__(512, 2) mega_fwd(Params p) {
    extern __shared__ __attribute__((aligned(16))) unsigned char smem[];
    cg::grid_group grid = cg::this_grid();
    char* sm = (char*)smem;
    int tid_ = threadIdx.x; asm volatile("" : "+v"(tid_)); const int tid = tid_, lane = tid & 63, wid = __builtin_amdgcn_readfirstlane(tid >> 6);
    const int G = gridDim.x, gw = blockIdx.x * 8 + wid, NGW = G * 8;
    unsigned char* ws = p.ws;
    unsigned* ctl = (unsigned*)(ws + WS_CTL);
    volatile LAS unsigned* XBW = (volatile LAS unsigned*)(sm + L_XB);
    if (threadIdx.x == 0) { XBW[0] = 0u; XBW[1] = 0u; }
    __syncthreads();
    const XcdBarrier xbar = xcd_barrier_post(ctl + 1024, XBW);
    bf16* WTIN = (bf16*)(ws + WS_WTIN); bf16* WTOUT = (bf16*)(ws + WS_WTOUT); bf16* W1T = (bf16*)(ws + WS_W1T); bf16* W2T = (bf16*)(ws + WS_W2T);
    float* PB = (float*)(ws + WS_PB); bf16* KC = (bf16*)(ws + WS_KC); bf16* VC = (bf16*)(ws + WS_VC); float* AUX = (float*)(ws + WS_AUX);
    bf16* H = (bf16*)(ws + WS_H); bf16* PROJ = (bf16*)(ws + WS_PROJ);

    {
        float* scr = (float*)(sm + wid * 16384);
        constexpr int I_IN = 16 * 128, I_OUT = 16 * 32, I_W1 = 32 * 2, I_W2 = 2;
        constexpr int NITEMS = 2 * I_IN + 2 * I_OUT + 4 * I_W1 + 4 * I_W2;
        for (int it = gw; it < NITEMS; it += NGW) {
            int r = it;
            if (r < 2 * I_IN) { const int l = r / I_IN; transpose_item(p.w_in + (size_t)l * D * DIN, D, DIN, WTIN + (size_t)l * NP * D, 128, true, scr, r % I_IN, lane); continue; } r -= 2 * I_IN;
            if (r < 2 * I_OUT) { const int l = r / I_OUT; transpose_item(p.w_out + (size_t)l * D * D, D, D, WTOUT + (size_t)l * D * D, 32, false, scr, r % I_OUT, lane); continue; } r -= 2 * I_OUT;
            if (r < 4 * I_W1) { const int q = r / I_W1, l = q >> 1, kv = q & 1; transpose_item((kv ? p.w1_v : p.w1_k) + (size_t)l * 2048 * 64, 2048, 64, W1T + (size_t)q * 64 * 2048, 2, false, scr, r % I_W1, lane); continue; } r -= 4 * I_W1;
            { const int q = r / I_W2, l = q >> 1, kv = q & 1; transpose_item((kv ? p.w2_v : p.w2_k) + (size_t)l * 64 * 64, 64, 64, W2T + (size_t)q * 64 * 64, 2, false, scr, r % I_W2, lane); }
        }
        for (int it = gw; it < 256; it += NGW) {
            const int q = it >> 6, e = it & 63, l = q >> 1, kv = q & 1;
            const float* pos = (kv ? p.pos_v : p.pos_k) + (size_t)l * 2048; const float* w1 = (kv ? p.w1_v : p.w1_k) + (size_t)l * 2048 * 64;
            float s = 0.f;
            for (int f = lane; f < 2048; f += 64) s += pos[f] * w1[(size_t)f * 64 + e];
            s = wave_sum(s);
            if (lane == 0) PB[it] = s;
        }
        for (int r = gw; r < M; r += 4 * NGW) norm_rows4<true>(const_cast<float*>(p.x), p.norm_g, H, r, NGW, lane);
    }
    if (gridDim.y == 0x7fffu) grid.sync();
    xcd_barrier(XcdBarrier{ctl + 1024, xb_xcc_id(), (volatile LAS unsigned*)(sm + L_XB)});

    for (int l = 0; l < 2; ++l) {
        for (int rep1 = 0; rep1 < REP_P1; ++rep1) {
            pg8::Gemm g{H, WTIN + (size_t)l * NP * D, M, NP, D}; pg8::StaticOrder So; So.init(M, NP, G, (int)blockIdx.x);
            EpiProj E{PROJ, AUX};
            pg8::gemm_phase<EpiProj, pg8::StaticOrder, true, true>((PG8_LAS unsigned char*)smem, g, So, E);
        }
        xcd_barrier(XcdBarrier{ctl + 1024, xb_xcc_id(), (volatile LAS unsigned*)(sm + L_XB)});
        for (int u = next_unit(ctl + 2 * l, sm); u < 2816;) {
            int nxt_ = 0; if (threadIdx.x == 0) nxt_ = (int)atomicAdd(ctl + 2 * l, 1u);
            if (u < 768) { const int k = u / 192, bh = u % 192;
                fox_unit(PROJ, AUX, p.b_f + 6 * l, H, sm, bh / 6, bh % 6, 7 - k, true); fox_unit(PROJ, AUX, p.b_f + 6 * l, H, sm, bh / 6, bh % 6, k, false); }
            else if (u < 2304) { const int v = u - 768; const int qb = 7 - v / 192, bh = v % 192; sb_unit(PROJ, H, sm, bh / 6, bh % 6, qb); }
            else { const int v = u - 2304; const int b = v >> 4, kv = (v >> 3) & 1, nt = v & 7; const int q = 2 * l + kv;
                   cmp_unit(PROJ, W1T + (size_t)q * 64 * 2048, W2T + (size_t)q * 64 * 64, PB + q * 64, kv ? VC : KC, kv ? C_NVC : C_NKC, sm, b, nt); }
            { volatile LAS int* slot = (volatile LAS int*)(sm + L_MISC); __syncthreads(); if (threadIdx.x == 0) *slot = nxt_; __syncthreads(); u = *slot; }
        }
        xcd_barrier(XcdBarrier{ctl + 1024, xb_xcc_id(), (volatile LAS unsigned*)(sm + L_XB)});
        for (int u = next_unit(ctl + 2 * l + 1, sm); u < 1024;) {
            int nxt_ = 0; if (threadIdx.x == 0) nxt_ = (int)atomicAdd(ctl + 2 * l + 1, 1u);
            nsa_unit(PROJ, AUX, KC, VC, H, sm, u & 31, 31 - (u >> 5));
            { volatile LAS int* slot = (volatile LAS int*)(sm + L_MISC); __syncthreads(); if (threadIdx.x == 0) *slot = nxt_; __syncthreads(); u = *slot; }
        }
        xcd_barrier(XcdBarrier{ctl + 1024, xb_xcc_id(), (volatile LAS unsigned*)(sm + L_XB)});
        {
            pg8::Gemm g{H, WTOUT + (size_t)l * D * D, M, D, D}; pg8::StaticOrder So; So.init(M, D, G, (int)blockIdx.x);
            EpiOut E{l == 0 ? p.x : p.out, p.out};
            pg8::gemm_phase<EpiOut, pg8::StaticOrder, true, true>((PG8_LAS unsigned char*)smem, g, So, E);
        }
        xcd_barrier(XcdBarrier{ctl + 1024, xb_xcc_id(), (volatile LAS unsigned*)(sm + L_XB)});
        { int t5 = threadIdx.x; asm volatile("" : "+v"(t5)); const int lane5 = t5 & 63, gw5 = blockIdx.x * 8 + __builtin_amdgcn_readfirstlane(t5 >> 6);
        if (l == 0) { for (int r = gw5; r < M; r += 4 * NGW) norm_rows4<true>(p.out, p.norm_g + D, H, r, NGW, lane5); xcd_barrier(XcdBarrier{ctl + 1024, xb_xcc_id(), (volatile LAS unsigned*)(sm + L_XB)}); }
        else { for (int r = gw5; r < M; r += 4 * NGW) norm_rows4<false>(p.out, p.final_g, nullptr, r, NGW, lane5); } }
    }
}

extern "C" void kernel_launch(void* const* d_in, const int* in_sizes, int n_in, void* d_out, int out_size, void* d_ws, size_t ws_size, hipStream_t stream) {
    static int grid = 0;
    if (grid == 0) {
        if (n_in != 12 || out_size != M * D || ws_size < WS_END) { fprintf(stderr, "kernel_launch: unexpected shapes (n_in %d out %d ws %zu)\n", n_in, out_size, ws_size); grid = -1; return; }
        int dev = 0, cus = 0, per_cu = 0;
        hipGetDevice(&dev); hipDeviceGetAttribute(&cus, hipDeviceAttributeMultiprocessorCount, dev);
        if (hipFuncSetAttribute((const void*)mega_fwd, hipFuncAttributeMaxDynamicSharedMemorySize, LDS_BYTES) != hipSuccess) { fprintf(stderr, "kernel_launch: hipFuncSetAttribute failed\n"); grid = -1; return; }
        if (hipOccupancyMaxActiveBlocksPerMultiprocessor(&per_cu, (const void*)mega_fwd, 512, LDS_BYTES) != hipSuccess || per_cu < 1) { fprintf(stderr, "kernel_launch: occupancy query failed (%d)\n", per_cu); per_cu = 1; }
        (void)hipGetLastError();
        grid = cus * per_cu;
    }
    if (grid < 0) return;
    hipMemsetAsync((char*)d_ws + WS_CTL, 0, CTL_BYTES, stream);
    Params p{};
    p.x = (const float*)d_in[0]; p.norm_g = (const float*)d_in[1]; p.w_in = (const float*)d_in[2]; p.b_f = (const float*)d_in[3];
    p.pos_k = (const float*)d_in[4]; p.w1_k = (const float*)d_in[5]; p.w2_k = (const float*)d_in[6];
    p.pos_v = (const float*)d_in[7]; p.w1_v = (const float*)d_in[8]; p.w2_v = (const float*)d_in[9];
    p.w_out = (const float*)d_in[10]; p.final_g = (const float*)d_in[11]; p.out = (float*)d_out; p.ws = (unsigned char*)d_ws;
    void* args[] = {&p};
    const hipError_t e = hipLaunchCooperativeKernel((const void*)mega_fwd, dim3(grid), dim3(512), args, LDS_BYTES, stream);
    if (e != hipSuccess) fprintf(stderr, "cooperative launch failed: %s (grid %d)\n", hipGetErrorString(e), grid);
}
```

```cpp
#include <hip/hip_runtime.h>
#include <hip/hip_cooperative_groups.h>
#include <cstdio>
#include <cstdint>
namespace cg = cooperative_groups;
namespace pg8 {
#define PG8_LAS __attribute__((address_space(3)))
typedef unsigned short bf16_t;
typedef short bf16x8 __attribute__((ext_vector_type(8)));
typedef float f32x4 __attribute__((ext_vector_type(4)));
typedef unsigned u32x4 __attribute__((ext_vector_type(4)));
constexpr int BM = 256, BK = 64, HALF = 128, HTB = HALF * BK * 2  , STAGE_BYTES = 8 * HTB, NXCD = 8, WGM = 8;

__host__ __device__ __forceinline__ int lds_byte(int r, int c) { const int st = (r >> 4) * 2 + (c >> 5), rr = r & 15, cc = c & 31, ob = rr * 64 + cc * 2; return st * 1024 + (ob ^ (((ob >> 9) & 1) << 5)); }
__host__ __device__ __forceinline__ void stage_rc(int b, int& R, int& C) { const int st = b / 1024, sb = b % 1024, swz = sb ^ (((sb >> 9) & 1) << 5); R = (st >> 1) * 16 + swz / 64; C = (st & 1) * 32 + (swz % 64) / 2; }
__host__ __device__ __forceinline__ int perm32(int rho) { const int n = rho >> 4, i = rho & 15; return 8 * (i >> 2) + 4 * n + (i & 3); }

struct Unit { int pm, pn; };
struct Gemm { const bf16_t* A; const bf16_t* Bt; int M, N, K; };

struct StaticOrder {
    int nM, nN, nwg, G, c;
    __host__ __device__ void init(int M, int N, int G_, int c_) { nM = M / BM; nN = N / BM; nwg = nM * nN; G = G_; c = c_; }
    __host__ __device__ bool next(int i, Unit& u) const {
        const long L = (long)i * G + c; if (L >= nwg) return false;
        int wgid = (int)L; { const int q = nwg / NXCD, r = nwg % NXCD, xcd = wgid % NXCD, off = wgid / NXCD; wgid = (xcd < r ? xcd * (q + 1) : r * (q + 1) + (xcd - r) * q) + off; }
        const int nig = WGM * nN, gid = wgid / nig, fm = gid * WGM, gsz = (nM - fm) < WGM ? (nM - fm) : WGM;
        u.pm = fm + ((wgid % nig) % gsz); u.pn = (wgid % nig) / gsz; return true;
    }
    __device__ __forceinline__ void a_ready(const Unit&) const {}
    __device__ __forceinline__ void done(const Unit&) const {}
};

__device__ __forceinline__ unsigned cvt_pk_bf16(float lo, float hi) { unsigned r; asm volatile("v_cvt_pk_bf16_f32 %0, %1, %2" : "=v"(r) : "v"(lo), "v"(hi)); return r; }
template <class Epi, class Sched, bool ALIGN_EPI = false, bool SP2 = false>
__device__ __forceinline__ void gemm_phase(PG8_LAS unsigned char* lds, const Gemm g, const Sched& S, const Epi& E) {
    int tid_ = threadIdx.x; asm volatile("" : "+v"(tid_)); const int tid = tid_, wid = __builtin_amdgcn_readfirstlane(tid >> 6), lane = tid & 63, wr = wid >> 2, wc = wid & 3, fr = lane & 15, fq = lane >> 4;
    const int K = g.K, nt = K / BK;
    unsigned voffA[2], voffB[2];
#pragma unroll
    for (int i = 0; i < 2; ++i) { int R, C; stage_rc(tid * 16 + i * 8192, R, C); const int Rb = Epi::PERM ? ((R & ~31) + perm32(R & 31)) : R;
        voffA[i] = (unsigned)(R * K + C) * 2u; voffB[i] = (unsigned)(Rb * K + C) * 2u; }
    const size_t kstep = (size_t)(BK * 2);
    const size_t hstep = (size_t)HALF * K * 2;
    const size_t tstep = 2 * hstep;
    const unsigned ldsw = (unsigned)wid * 1024u;
    const int aoff = lds_byte(wr * 64 + fr, fq * 8), boff = lds_byte(wc * 32 + fr, fq * 8);
#define PG8_SA(b, h) (((b) * 2 + (h)) * HTB)
#define PG8_SB(b, h) ((4 + (b) * 2 + (h)) * HTB)
#define PG8_STAGE(bufoff, gbase, voff) do { _Pragma("unroll") for (int _i = 0; _i < 2; ++_i) \
        __builtin_amdgcn_global_load_lds((const unsigned*)((const char*)(gbase) + (voff)[_i]), (PG8_LAS unsigned*)(lds + (bufoff) + ldsw + _i * 8192), 16, 0, 0); } while (0)
#define PG8_LDA(dst, b, h) do { _Pragma("unroll") for (int m = 0; m < 4; ++m) _Pragma("unroll") for (int k = 0; k < 2; ++k) dst[m][k] = *(const PG8_LAS bf16x8*)(lds + PG8_SA(b, h) + aoff + m * 2048 + k * 1024); } while (0)
#define PG8_LDB(dst, b, h) do { _Pragma("unroll") for (int n = 0; n < 2; ++n) _Pragma("unroll") for (int k = 0; k < 2; ++k) dst[n][k] = *(const PG8_LAS bf16x8*)(lds + PG8_SB(b, h) + boff + n * 2048 + k * 1024); } while (0)
#define PG8_MMA(ai, bj, At, Bt) do { __builtin_amdgcn_s_setprio(1); _Pragma("unroll") for (int m = 0; m < 4; ++m) _Pragma("unroll") for (int n = 0; n < 2; ++n) _Pragma("unroll") for (int k = 0; k < 2; ++k) \
        acc[ai][bj][m][n] = __builtin_amdgcn_mfma_f32_16x16x32_bf16(Bt[n][k], At[m][k], acc[ai][bj][m][n], 0, 0, 0); __builtin_amdgcn_s_setprio(0); } while (0)
#define PG8_WAIT_V(n) asm volatile("s_waitcnt vmcnt(" #n ")" ::: "memory")
#define PG8_WAIT_L(n) asm volatile("s_waitcnt lgkmcnt(" #n ")" ::: "memory")
#define PG8_BAR __builtin_amdgcn_s_barrier()
#define PG8_SCHED __builtin_amdgcn_sched_barrier(0)
    Unit cur, nxt; int ui = 0;
    if (!S.next(0, cur)) return;
    f32x4 acc[2][2][4][2];
#pragma unroll
    for (int a = 0; a < 2; ++a)
#pragma unroll
        for (int b = 0; b < 2; ++b)
#pragma unroll
            for (int m = 0; m < 4; ++m)
#pragma unroll
                for (int n = 0; n < 2; ++n) acc[a][b][m][n] = (f32x4){0.f, 0.f, 0.f, 0.f};
    bf16x8 At[4][2], B0[2][2], B1[2][2];
    const char* cA = (const char*)g.A + (size_t)cur.pm * tstep; const char* cB = (const char*)g.Bt + (size_t)cur.pn * tstep;
    S.a_ready(cur);
    if constexpr (SP2) {
        PG8_STAGE(PG8_SB(0, 0), cB, voffB); PG8_STAGE(PG8_SB(0, 1), cB + hstep, voffB); PG8_STAGE(PG8_SA(0, 0), cA, voffA); PG8_STAGE(PG8_SA(0, 1), cA + hstep, voffA);
        if (wr == 1) PG8_BAR;
        PG8_WAIT_V(2); PG8_BAR;
        PG8_STAGE(PG8_SB(1, 0), cB + kstep, voffB); PG8_STAGE(PG8_SA(1, 0), cA + kstep, voffA); PG8_STAGE(PG8_SB(1, 1), cB + hstep + kstep, voffB);
        PG8_WAIT_V(6); PG8_BAR;
    } else {
        PG8_STAGE(PG8_SB(0, 0), cB, voffB); PG8_STAGE(PG8_SA(0, 0), cA, voffA); PG8_STAGE(PG8_SB(0, 1), cB + hstep, voffB); PG8_STAGE(PG8_SA(0, 1), cA + hstep, voffA);
        if (wr == 1) PG8_BAR;
        PG8_WAIT_V(4); PG8_BAR;
        PG8_STAGE(PG8_SB(1, 0), cB + kstep, voffB); PG8_STAGE(PG8_SA(1, 0), cA + kstep, voffA); PG8_STAGE(PG8_SB(1, 1), cB + hstep + kstep, voffB);
        PG8_WAIT_V(6); PG8_BAR;
    }
    for (;;) {
        const bool has_next = S.next(ui + 1, nxt);
        const char* nA = has_next ? (const char*)g.A + (size_t)nxt.pm * tstep : cA; const char* nB = has_next ? (const char*)g.Bt + (size_t)nxt.pn * tstep : cB;
        for (int t = 0; t < nt; t += 2) {
            const bool last = (t == nt - 2);
            const char* a1 = cA + (size_t)(t + 1) * kstep;
            const char* a2 = last ? nA : cA + (size_t)(t + 2) * kstep; const char* b2 = last ? nB : cB + (size_t)(t + 2) * kstep;
            const char* a3 = a2 + kstep; const char* b3 = b2 + kstep;
            if (last && has_next) S.a_ready(nxt);
            if constexpr (SP2) {
            PG8_LDB(B0, 0, 0); PG8_LDB(B1, 0, 1); PG8_SCHED; PG8_LDA(At, 0, 0); PG8_STAGE(PG8_SA(1, 1), a1 + hstep, voffA);
            PG8_WAIT_V(8); PG8_WAIT_L(0); PG8_BAR; PG8_MMA(0, 0, At, B0); PG8_MMA(0, 1, At, B1); PG8_BAR; PG8_SCHED;
            PG8_LDA(At, 0, 1); PG8_STAGE(PG8_SB(0, 0), b2, voffB); PG8_STAGE(PG8_SB(0, 1), b2 + hstep, voffB); PG8_STAGE(PG8_SA(0, 0), a2, voffA);
            PG8_WAIT_V(8); PG8_WAIT_L(0); PG8_BAR; PG8_MMA(1, 0, At, B0); PG8_MMA(1, 1, At, B1); PG8_BAR; PG8_SCHED;
            PG8_LDB(B0, 1, 0); PG8_LDB(B1, 1, 1); PG8_SCHED; PG8_LDA(At, 1, 0); PG8_STAGE(PG8_SA(0, 1), a2 + hstep, voffA);
            PG8_WAIT_V(8); PG8_WAIT_L(0); PG8_BAR; PG8_MMA(0, 0, At, B0); PG8_MMA(0, 1, At, B1); PG8_BAR; PG8_SCHED;
            PG8_LDA(At, 1, 1); PG8_STAGE(PG8_SB(1, 0), b3, voffB); PG8_STAGE(PG8_SB(1, 1), b3 + hstep, voffB); PG8_STAGE(PG8_SA(1, 0), a3, voffA);
            PG8_WAIT_V(8); PG8_WAIT_L(0); PG8_BAR; PG8_MMA(1, 0, At, B0); PG8_MMA(1, 1, At, B1); PG8_BAR; PG8_SCHED;
            } else {
            PG8_LDB(B0, 0, 0); PG8_SCHED; PG8_LDA(At, 0, 0); PG8_STAGE(PG8_SA(1, 1), a1 + hstep, voffA);
            PG8_WAIT_L(8); PG8_BAR; PG8_WAIT_L(0); PG8_MMA(0, 0, At, B0); PG8_BAR; PG8_SCHED;
            PG8_LDB(B1, 0, 1); PG8_STAGE(PG8_SB(0, 0), b2, voffB);
            PG8_BAR; PG8_WAIT_L(0); PG8_MMA(0, 1, At, B1); PG8_BAR;
            PG8_LDA(At, 0, 1); PG8_STAGE(PG8_SA(0, 0), a2, voffA);
            PG8_BAR; PG8_WAIT_L(0); PG8_MMA(1, 0, At, B0); PG8_BAR; PG8_SCHED;
            PG8_STAGE(PG8_SB(0, 1), b2 + hstep, voffB);
            PG8_WAIT_V(6); PG8_BAR; PG8_MMA(1, 1, At, B1); PG8_BAR;
            PG8_LDB(B0, 1, 0); PG8_SCHED; PG8_LDA(At, 1, 0); PG8_STAGE(PG8_SA(0, 1), a2 + hstep, voffA);
            PG8_WAIT_L(8); PG8_BAR; PG8_WAIT_L(0); PG8_MMA(0, 0, At, B0); PG8_BAR; PG8_SCHED;
            PG8_LDB(B1, 1, 1); PG8_STAGE(PG8_SB(1, 0), b3, voffB);
            PG8_BAR; PG8_WAIT_L(0); PG8_MMA(0, 1, At, B1); PG8_BAR;
            PG8_LDA(At, 1, 1); PG8_STAGE(PG8_SA(1, 0), a3, voffA);
            PG8_BAR; PG8_WAIT_L(0); PG8_MMA(1, 0, At, B0); PG8_BAR; PG8_SCHED;
            PG8_STAGE(PG8_SB(1, 1), b3 + hstep, voffB);
            PG8_WAIT_V(6); PG8_BAR; PG8_MMA(1, 1, At, B1); PG8_BAR;
            }
        }
        if constexpr (ALIGN_EPI) { if (wr == 0) PG8_BAR; }
        if constexpr (!Epi::AFTER_DRAIN) { E(acc, cur, wr, wc, fr, fq); S.done(cur); }
        if (!has_next) break;
#pragma unroll
        for (int a = 0; a < 2; ++a)
#pragma unroll
            for (int b = 0; b < 2; ++b)
#pragma unroll
                for (int m = 0; m < 4; ++m)
#pragma unroll
                    for (int n = 0; n < 2; ++n) acc[a][b][m][n] = (f32x4){0.f, 0.f, 0.f, 0.f};
        cur = nxt; cA = nA; cB = nB; ++ui;
        if constexpr (ALIGN_EPI) { if (wr == 1) PG8_BAR; }
    }
    PG8_WAIT_V(0);
    if constexpr (!ALIGN_EPI) { if (wr == 0) PG8_BAR; }
    PG8_BAR;
    if constexpr (Epi::AFTER_DRAIN) { E.fused(acc, cur, wr, wc, fr, fq, lds, wid, lane); S.done(cur); }
#undef PG8_SA
#undef PG8_SB
#undef PG8_STAGE
#undef PG8_LDA
#undef PG8_LDB
#undef PG8_MMA
#undef PG8_WAIT_V
#undef PG8_WAIT_L
#undef PG8_BAR
#undef PG8_SCHED
}
}

#define LAS __attribute__((address_space(3)))
#define DI __device__ __forceinline__
typedef unsigned short bf16;
typedef short bf16x8 __attribute__((ext_vector_type(8)));
typedef short s16x4 __attribute__((ext_vector_type(4)));
typedef float f32x4 __attribute__((ext_vector_type(4)));
typedef float f32x16 __attribute__((ext_vector_type(16)));
typedef unsigned u32x4 __attribute__((ext_vector_type(4)));
typedef unsigned u32x2 __attribute__((ext_vector_type(2)));
typedef LAS const char* lds_cptr;
typedef short v4i16_t __attribute__((ext_vector_type(4)));
typedef float f32x2_t __attribute__((ext_vector_type(2)));
typedef __bf16 bf16x2_t __attribute__((ext_vector_type(2)));

constexpr int S = 2048, NB = 32, M = NB * S, D = 1024, NP = 4096, DIN = 3986;
constexpr int C_FQ = 0, C_FK = 384, C_FV = 768, C_FZ = 1152, C_SQ = 1536, C_SK = 1920, C_SV = 2304, C_SZ = 2688, C_NQ = 3072, C_NKC = 3328, C_NVC = 3392,
              C_NKS = 3456, C_NVS = 3520, C_NKW = 3584, C_NVW = 3648, C_NZ = 3712;
constexpr size_t MiB = 1u << 20;
constexpr size_t WS_CTL = 0, CTL_BYTES = 32768;
constexpr size_t WS_WTIN = 2 * MiB;
constexpr size_t WS_WTOUT = 18 * MiB;
constexpr size_t WS_W1T = 22 * MiB;
constexpr size_t WS_W2T = 23 * MiB;
constexpr size_t WS_PB = 23 * MiB + 65536;
constexpr size_t WS_KC = 24 * MiB;
constexpr size_t WS_VC = 25 * MiB;
constexpr size_t WS_AUX = 26 * MiB;
constexpr size_t WS_H = 64 * MiB;
constexpr size_t WS_PROJ = 192 * MiB;
constexpr size_t WS_END = 704 * MiB;
constexpr int STG = 18432;
constexpr int L_CBUF = 36864;
constexpr int L_IMP = 45056;
constexpr int L_SELM = 78848;
constexpr int L_MISC = 79104;
constexpr int L_RED = 36864;
constexpr int L_HID = 69632;
constexpr int L_TACC = 81920;
constexpr int L_XB = 147456;
constexpr int LDS_BYTES = 147712;
constexpr float C2 = 0.125f * 1.4426950408889634f;
#ifndef REP_P1
#define REP_P1 1
#endif
#ifndef REP_P2
#define REP_P2 1
#endif
#ifndef REP_P3
#define REP_P3 1
#endif
constexpr float NEGX = -1e30f, MINIT = -1e28f;

DI unsigned f2bf(float f) { unsigned u = __float_as_uint(f); return (u + 0x7fffu + ((u >> 16) & 1u)) >> 16; }
DI float bf2f(unsigned h) { return __uint_as_float(h << 16); }
DI unsigned cvtpk(float lo, float hi) { f32x2_t v = {lo, hi}; bf16x2_t b = __builtin_convertvector(v, bf16x2_t); return __builtin_bit_cast(unsigned, b); }
DI float ex2(float x) { return __builtin_amdgcn_exp2f(x); }
DI float wave_sum(float v) {
#pragma unroll
    for (int o = 1; o < 64; o <<= 1) v += __shfl_xor(v, o);
    return v;
}
DI float sigm_f(float z) { return __builtin_amdgcn_rcpf(1.f + ex2(-1.4426950408889634f * z)); }
DI float silu_f(float z) { return z * sigm_f(z); }
DI int crow(int i, int hi) { return (i & 3) + 8 * (i >> 2) + 4 * hi; }
DI s16x4 vtr(lds_cptr p) { return __builtin_bit_cast(s16x4, __builtin_amdgcn_ds_read_tr16_b64_v4i16((LAS v4i16_t*)p)); }
#define MFMA32(a, b, c) __builtin_amdgcn_mfma_f32_32x32x16_bf16((a), (b), (c), 0, 0, 0)
#define MFMA16(a, b, c) __builtin_amdgcn_mfma_f32_16x16x32_bf16((a), (b), (c), 0, 0, 0)

DI void kv_issue(const bf16* Kt, const bf16* Vt, int pitch, int wid, int lane, u32x4& kr, u32x4& vr) {
    kr = *(const u32x4*)(Kt + (size_t)lane * pitch + 8 * wid);
    vr = *(const u32x4*)(Vt + (size_t)(16 * (wid & 3) + (lane >> 2)) * pitch + (wid >> 2) * 32 + (lane & 3) * 8);
}
DI void kv_commit(char* buf, int tid, int wid, int lane, const u32x4& kr, const u32x4& vr, const u32x4& ar) {
    *(u32x4*)(buf + tid * 16) = kr;
    *(u32x4*)(buf + 9216 + tid * 16) = vr;
    if (wid == 0) *(u32x4*)(buf + 8192 + lane * 16) = ar;
}
DI void qk_tile(const char* kb, const bf16x8 (&qr)[5], int r32, int hi, f32x16& x0, f32x16& x1) {
    bf16x8 kf[10];
#pragma unroll
    for (int d0 = 0; d0 < 4; ++d0) {
        kf[2 * d0] = *(const bf16x8*)(kb + (2 * d0 + hi) * 1024 + r32 * 16);
        kf[2 * d0 + 1] = *(const bf16x8*)(kb + (2 * d0 + hi) * 1024 + 512 + r32 * 16);
    }
    kf[8] = *(const bf16x8*)(kb + 8192 + r32 * 16);
    kf[9] = *(const bf16x8*)(kb + 8192 + 512 + r32 * 16);
    asm volatile("s_waitcnt lgkmcnt(0)" ::: "memory");
#pragma unroll
    for (int i = 0; i < 16; ++i) { x0[i] = 0.f; x1[i] = 0.f; }
#pragma unroll
    for (int d0 = 0; d0 < 5; ++d0) { x0 = MFMA32(kf[2 * d0], qr[d0], x0); x1 = MFMA32(kf[2 * d0 + 1], qr[d0], x1); }
}
DI void v_load(const char* vb, int lane, int hi, bf16x8 (&vf)[8]) {
    const lds_cptr vp = (lds_cptr)vb + ((lane >> 4) & 1) * 32 + (lane & 3) * 8 + (4 * hi + ((lane & 15) >> 2)) * 64;
#pragma unroll
    for (int ks = 0; ks < 4; ++ks) {
        { const s16x4 lo = vtr(vp + ks * 1024), hh = vtr(vp + ks * 1024 + 512); vf[ks] = (bf16x8){lo[0], lo[1], lo[2], lo[3], hh[0], hh[1], hh[2], hh[3]}; }
        { const s16x4 lo = vtr(vp + 4096 + ks * 1024), hh = vtr(vp + 4096 + ks * 1024 + 512); vf[4 + ks] = (bf16x8){lo[0], lo[1], lo[2], lo[3], hh[0], hh[1], hh[2], hh[3]}; }
    }
    asm volatile("" ::: "memory");
}
DI void pv_tile(const bf16x8 (&vf)[8], const f32x16& p0, const f32x16& p1, f32x16& o0, f32x16& o1) {
    u32x4 w[4];
#pragma unroll
    for (int j = 0; j < 4; ++j) { w[0][j] = cvtpk(p0[2 * j], p0[2 * j + 1]); w[1][j] = cvtpk(p0[8 + 2 * j], p0[9 + 2 * j]);
                                  w[2][j] = cvtpk(p1[2 * j], p1[2 * j + 1]); w[3][j] = cvtpk(p1[8 + 2 * j], p1[9 + 2 * j]); }
#pragma unroll
    for (int ks = 0; ks < 4; ++ks) { const bf16x8 pb = __builtin_bit_cast(bf16x8, w[ks]); o0 = MFMA32(vf[ks], pb, o0); o1 = MFMA32(vf[4 + ks], pb, o1); }
}
DI void mask_tile(f32x16& x0, f32x16& x1, int klo, int khi, int hi) {
#pragma unroll
    for (int i = 0; i < 16; ++i) { const int k = crow(i, hi); if (k < klo || k > khi) x0[i] = NEGX; if (k + 32 < klo || k + 32 > khi) x1[i] = NEGX; }
}
DI float tile_max(const f32x16& x0, const f32x16& x1) {
    float ma = __builtin_fmaxf(x0[0], x1[0]), mb = __builtin_fmaxf(x0[1], x1[1]);
#pragma unroll
    for (int i = 2; i < 16; i += 2) { ma = __builtin_fmaxf(__builtin_fmaxf(ma, x0[i]), x1[i]); mb = __builtin_fmaxf(__builtin_fmaxf(mb, x0[i + 1]), x1[i + 1]); }
    const float mx = __builtin_fmaxf(ma, mb);
    return __builtin_fmaxf(mx, __shfl_xor(mx, 32));
}
DI void smx_tile(f32x16& x0, f32x16& x1, float& m, float& l, f32x16& o0, f32x16& o1) {
    const float mn = fmaxf(m, tile_max(x0, x1) * C2);
    const float al = ex2(m - mn); m = mn; l *= al;
    if (__any(al != 1.f)) {
#pragma unroll
        for (int i = 0; i < 16; ++i) { o0[i] *= al; o1[i] *= al; }
    }
    float s = 0.f;
#pragma unroll
    for (int i = 0; i < 16; ++i) { x0[i] = ex2(fmaf(x0[i], C2, -mn)); x1[i] = ex2(fmaf(x1[i], C2, -mn)); s += x0[i] + x1[i]; }
    l += s;
}
DI void smx_tile_sel(f32x16& x0, f32x16& x1, float& m, float& l, f32x16& o0, f32x16& o1, bool sel) {
    const float tm = tile_max(x0, x1) * C2;
    const float mn = sel ? fmaxf(m, tm) : m;
    const float al = ex2(m - mn); m = mn; l *= al;
    if (__any(al != 1.f)) {
#pragma unroll
        for (int i = 0; i < 16; ++i) { o0[i] *= al; o1[i] *= al; }
    }
    const float sub = sel ? mn : 3.0e38f;
    float s = 0.f;
#pragma unroll
    for (int i = 0; i < 16; ++i) { x0[i] = ex2(fmaf(x0[i], C2, -sub)); x1[i] = ex2(fmaf(x1[i], C2, -sub)); s += x0[i] + x1[i]; }
    l += s;
}
DI void smx_stats(const f32x16& x0, const f32x16& x1, float& m, float& l) {
    const float mn = fmaxf(m, tile_max(x0, x1) * C2);
    l *= ex2(m - mn); m = mn;
    float s = 0.f;
#pragma unroll
    for (int i = 0; i < 16; ++i) s += ex2(fmaf(x0[i], C2, -mn)) + ex2(fmaf(x1[i], C2, -mn));
    l += s;
}
DI void sb_tile(f32x16& x0, f32x16& x1, float& R, int hi) {
#pragma unroll
    for (int i = 0; i < 16; ++i) { x0[i] = __builtin_amdgcn_rcpf(1.f + ex2(x0[i] * C2)); x1[i] = __builtin_amdgcn_rcpf(1.f + ex2(x1[i] * C2)); }
    float qp[8], pq[8];
#pragma unroll
    for (int g = 0; g < 4; ++g) { qp[g] = (x0[4 * g] * x0[4 * g + 1]) * (x0[4 * g + 2] * x0[4 * g + 3]); qp[4 + g] = (x1[4 * g] * x1[4 * g + 1]) * (x1[4 * g + 2] * x1[4 * g + 3]); }
#pragma unroll
    for (int g = 0; g < 8; ++g) pq[g] = __shfl_xor(qp[g], 32);
    float Sfx = R;
#pragma unroll
    for (int gg = 7; gg >= 0; --gg) {
        float base = Sfx * (hi ? 1.f : pq[gg]);
        f32x16& x = (gg >= 4) ? x1 : x0; const int q4 = 4 * (gg & 3);
        const float r3 = x[q4 + 3], r2 = x[q4 + 2], r1 = x[q4 + 1], r0 = x[q4];
        x[q4 + 3] = fmaf(-r3, base, base); base *= r3;
        x[q4 + 2] = fmaf(-r2, base, base); base *= r2;
        x[q4 + 1] = fmaf(-r1, base, base); base *= r1;
        x[q4] = fmaf(-r0, base, base);
        Sfx *= qp[gg] * pq[gg];
    }
    R = Sfx;
}
DI void write_out(const f32x16& o0, const f32x16& o1, float sc, const bf16* zrow, bf16* orow, int hi) {
#pragma unroll
    for (int d0 = 0; d0 < 2; ++d0)
#pragma unroll
        for (int gq = 0; gq < 4; ++gq) {
            const int d = 32 * d0 + 8 * gq + 4 * hi;
            const u32x2 zz = *(const u32x2*)(zrow + d);
            const f32x16& o = d0 ? o1 : o0;
            const float v0 = o[4 * gq] * sc * silu_f(bf2f(zz.x & 0xffffu)), v1 = o[4 * gq + 1] * sc * silu_f(bf2f(zz.x >> 16));
            const float v2 = o[4 * gq + 2] * sc * silu_f(bf2f(zz.y & 0xffffu)), v3 = o[4 * gq + 3] * sc * silu_f(bf2f(zz.y >> 16));
            u32x2 w; w.x = cvtpk(v0, v1); w.y = cvtpk(v2, v3);
            *(u32x2*)(orow + d) = w;
        }
}
DI void write_out_t(const f32x16& o0, const f32x16& o1, float sc, const bf16* zrow0, size_t zpitch, bf16* orow0, size_t opitch, float* st, int lane) {
    const int q = lane & 31, hi = lane >> 5;
#pragma unroll
    for (int d0 = 0; d0 < 2; ++d0)
#pragma unroll
        for (int gq = 0; gq < 4; ++gq) {
            const int ch = 8 * d0 + 2 * gq + hi; const f32x16& o = d0 ? o1 : o0;
            *(f32x4*)(st + q * 64 + ((ch ^ (q & 15)) << 2)) = (f32x4){o[4 * gq] * sc, o[4 * gq + 1] * sc, o[4 * gq + 2] * sc, o[4 * gq + 3] * sc};
        }
#pragma unroll
    for (int j = 0; j < 4; ++j) {
        const int row = (lane >> 3) + 8 * j, c = lane & 7;
        const f32x4 a = *(const f32x4*)(st + row * 64 + (((2 * c) ^ (row & 15)) << 2)), b = *(const f32x4*)(st + row * 64 + (((2 * c + 1) ^ (row & 15)) << 2));
        const u32x4 zz = *(const u32x4*)(zrow0 + (size_t)row * zpitch + 8 * c);
        u32x4 w;
        w.x = cvtpk(a[0] * silu_f(bf2f(zz.x & 0xffffu)), a[1] * silu_f(bf2f(zz.x >> 16)));
        w.y = cvtpk(a[2] * silu_f(bf2f(zz.y & 0xffffu)), a[3] * silu_f(bf2f(zz.y >> 16)));
        w.z = cvtpk(b[0] * silu_f(bf2f(zz.z & 0xffffu)), b[1] * silu_f(bf2f(zz.z >> 16)));
        w.w = cvtpk(b[2] * silu_f(bf2f(zz.w & 0xffffu)), b[3] * silu_f(bf2f(zz.w >> 16)));
        *(u32x4*)(orow0 + (size_t)row * opitch + 8 * c) = w;
    }
}
DI void write_out_z(const f32x16& o0, const f32x16& o1, float sc, const u32x4 (&zpre)[4], bf16* orow0, size_t opitch, float* st, int lane) {
    const int q = lane & 31, hi = lane >> 5;
#pragma unroll
    for (int d0 = 0; d0 < 2; ++d0)
#pragma unroll
        for (int gq = 0; gq < 4; ++gq) {
            const int ch = 8 * d0 + 2 * gq + hi; const f32x16& o = d0 ? o1 : o0;
            *(f32x4*)(st + q * 64 + ((ch ^ (q & 15)) << 2)) = (f32x4){o[4 * gq] * sc, o[4 * gq + 1] * sc, o[4 * gq + 2] * sc, o[4 * gq + 3] * sc};
        }
#pragma unroll
    for (int j = 0; j < 4; ++j) {
        const int row = (lane >> 3) + 8 * j, c = lane & 7;
        const f32x4 a = *(const f32x4*)(st + row * 64 + (((2 * c) ^ (row & 15)) << 2)), b = *(const f32x4*)(st + row * 64 + (((2 * c + 1) ^ (row & 15)) << 2));
        const u32x4 zz = zpre[j];
        u32x4 w;
        w.x = cvtpk(a[0] * silu_f(bf2f(zz.x & 0xffffu)), a[1] * silu_f(bf2f(zz.x >> 16)));
        w.y = cvtpk(a[2] * silu_f(bf2f(zz.y & 0xffffu)), a[3] * silu_f(bf2f(zz.y >> 16)));
        w.z = cvtpk(b[0] * silu_f(bf2f(zz.z & 0xffffu)), b[1] * silu_f(bf2f(zz.z >> 16)));
        w.w = cvtpk(b[2] * silu_f(bf2f(zz.w & 0xffffu)), b[3] * silu_f(bf2f(zz.w >> 16)));
        *(u32x4*)(orow0 + (size_t)row * opitch + 8 * c) = w;
    }
}
DI void write_out_zh(const f32x16& o0, const f32x16& o1, float sc, const u32x4 (&zpre)[2], const bf16* zrow0, size_t zpitch, bf16* orow0, size_t opitch, float* st, int lane) {
    const int q = lane & 31, hi = lane >> 5;
#pragma unroll
    for (int d0 = 0; d0 < 2; ++d0)
#pragma unroll
        for (int gq = 0; gq < 4; ++gq) {
            const int ch = 8 * d0 + 2 * gq + hi; const f32x16& o = d0 ? o1 : o0;
            *(f32x4*)(st + q * 64 + ((ch ^ (q & 15)) << 2)) = (f32x4){o[4 * gq] * sc, o[4 * gq + 1] * sc, o[4 * gq + 2] * sc, o[4 * gq + 3] * sc};
        }
#pragma unroll
    for (int j = 0; j < 4; ++j) {
        const int row = (lane >> 3) + 8 * j, c = lane & 7;
        const f32x4 a = *(const f32x4*)(st + row * 64 + (((2 * c) ^ (row & 15)) << 2)), b = *(const f32x4*)(st + row * 64 + (((2 * c + 1) ^ (row & 15)) << 2));
        const u32x4 zz = j < 2 ? zpre[j & 1] : *(const u32x4*)(zrow0 + (size_t)row * zpitch + 8 * c);
        u32x4 w;
        w.x = cvtpk(a[0] * silu_f(bf2f(zz.x & 0xffffu)), a[1] * silu_f(bf2f(zz.x >> 16)));
        w.y = cvtpk(a[2] * silu_f(bf2f(zz.y & 0xffffu)), a[3] * silu_f(bf2f(zz.y >> 16)));
        w.z = cvtpk(b[0] * silu_f(bf2f(zz.z & 0xffffu)), b[1] * silu_f(bf2f(zz.z >> 16)));
        w.w = cvtpk(b[2] * silu_f(bf2f(zz.w & 0xffffu)), b[3] * silu_f(bf2f(zz.w >> 16)));
        *(u32x4*)(orow0 + (size_t)row * opitch + 8 * c) = w;
    }
}
DI u32x4 split3(float a) {
    const unsigned h = f2bf(a); const float r1 = a - bf2f(h); const unsigned m = f2bf(r1); const unsigned l = f2bf(r1 - bf2f(m));
    u32x4 r; r.x = h | (m << 16); r.y = l; r.z = 0u; r.w = 0u; return r;
}
DI u32x4 pos_aug(int pos) {
    u32x4 r; r.x = f2bf((float)(pos & ~7)) | (f2bf((float)(pos & 7)) << 16); r.y = 0u; r.z = 0u; r.w = 0u; return r;
}


DI void fox_unit(const bf16* PR, const float* AUX, const float* bfp, bf16* MIX, char* sm, int b, int h, int qb, bool do_cs) {
    int tid_ = threadIdx.x; asm volatile("" : "+v"(tid_)); const int tid = tid_, lane = tid & 63, r32 = lane & 31, hi = lane >> 5, wid = __builtin_amdgcn_readfirstlane(tid >> 6);
    float* cbuf = (float*)(sm + L_CBUF); float* miscf = (float*)(sm + L_MISC);
    const int nkeys = 256 * (qb + 1), q0 = 256 * qb; const size_t rb = (size_t)b * S;
    if (do_cs) {
        float v[4]; float run = 0.f; const float bias = bfp[h];
#pragma unroll
        for (int e = 0; e < 4; ++e) { const int s = 4 * tid + e; float ls = 0.f;
            if (s < nkeys) { const float x = AUX[(rb + s) * 32 + h] + bias; ls = fminf(x, 0.f) - 0.6931471805599453f * __builtin_amdgcn_logf(1.f + ex2(-1.4426950408889634f * fabsf(x))); }
            run += ls; v[e] = run; }
        float tot = run;
#pragma unroll
        for (int o = 1; o < 64; o <<= 1) { const float y = __shfl_up(tot, o); if (lane >= o) tot += y; }
        if (lane == 63) miscf[24 + wid] = tot;
        __syncthreads();
        float off = tot - run;
        for (int w = 0; w < wid; ++w) off += miscf[24 + w];
#pragma unroll
        for (int e = 0; e < 4; ++e) cbuf[4 * tid + e] = v[e] + off;
        __syncthreads();
    }
    const int t = q0 + 32 * wid + r32;
    bf16x8 qr[5];
#pragma unroll
    for (int d0 = 0; d0 < 4; ++d0) qr[d0] = *(const bf16x8*)(PR + (rb + t) * NP + C_FQ + 64 * h + 16 * d0 + 8 * hi);
    { const short one = hi ? (short)0 : (short)0x3F80; qr[4] = (bf16x8){one, one, one, 0, 0, 0, 0, 0}; }
    const float cref = cbuf[q0];
    const bf16* Kb = PR + rb * NP + C_FK + 64 * h; const bf16* Vb = PR + rb * NP + C_FV + 64 * h;
    float m = MINIT, l = 0.f; f32x16 o0, o1;
#pragma unroll
    for (int i = 0; i < 16; ++i) { o0[i] = 0.f; o1[i] = 0.f; }
    unsigned z_ = 0u; asm volatile("" : "+v"(z_)); u32x4 kr, vr, ar = {z_, z_, z_, z_};
    const int wq0 = q0 + 32 * wid;
    u32x4 zpre[4];
    const bf16* zrow0 = PR + (rb + wq0) * NP + C_FZ + 64 * h;
    float q1 = 0.f;
#pragma unroll
    for (int d0 = 0; d0 < 4; ++d0)
#pragma unroll
        for (int j = 0; j < 8; ++j) q1 += fabsf(bf2f((unsigned)(unsigned short)qr[d0][j]));
    q1 += __shfl_xor(q1, 32);
    volatile LAS unsigned* kmx = (volatile LAS unsigned*)(sm + L_MISC) + 32;
    for (int it_ = -1, nt_ = (4 * qb + 4); it_ < nt_; ++it_) {
        const bool more_ = it_ + 1 < nt_;
        if (!more_) {
#pragma unroll
            for (int j = 0; j < 4; ++j) zpre[j] = *(const u32x4*)(zrow0 + (size_t)((lane >> 3) + 8 * j) * NP + 8 * (lane & 7));
        }
        if (more_) { const int kt = nt_ - 2 - it_; { kv_issue(Kb + (size_t)(64 * kt) * NP, Vb + (size_t)(64 * kt) * NP, NP, wid, lane, kr, vr);
          if (wid == 0) ar = split3(8.f * (cref - cbuf[64 * kt + lane])); } }
        if (it_ >= 0) { const int kt = nt_ - 1 - it_; const char* cb = sm + (it_ & 1) * STG; { if (64 * kt <= wq0 + 31) {
              unsigned kb_ = 0u;
#pragma unroll
              for (int w = 0; w < 8; ++w) { const unsigned v_ = kmx[(it_ & 1) * 8 + w]; kb_ = v_ > kb_ ? v_ : kb_; }
              const float ub = C2 * (q1 * bf2f(kb_) + 8.f * (cref - cbuf[64 * kt + 63]));
              if (!__all(ub - m < -160.f)) {
                  f32x16 x0, x1; qk_tile(cb, qr, r32, hi, x0, x1); bf16x8 vf[8]; v_load(cb + 9216, lane, hi, vf);
                  if (64 * kt + 63 > wq0) mask_tile(x0, x1, 0, t - 64 * kt, hi);
                  smx_tile(x0, x1, m, l, o0, o1);
                  pv_tile(vf, x0, x1, o0, o1); } } } }
        if (more_) { kv_commit(sm + ((it_ + 1) & 1) * STG, tid, wid, lane, kr, vr, ar);
            unsigned mk = (kr.x & 0x7fffu); { const unsigned t1 = (kr.x >> 16) & 0x7fffu; mk = t1 > mk ? t1 : mk; }
            { const unsigned t0 = kr.y & 0x7fffu, t1 = (kr.y >> 16) & 0x7fffu; mk = t0 > mk ? t0 : mk; mk = t1 > mk ? t1 : mk; }
            { const unsigned t0 = kr.z & 0x7fffu, t1 = (kr.z >> 16) & 0x7fffu; mk = t0 > mk ? t0 : mk; mk = t1 > mk ? t1 : mk; }
            { const unsigned t0 = kr.w & 0x7fffu, t1 = (kr.w >> 16) & 0x7fffu; mk = t0 > mk ? t0 : mk; mk = t1 > mk ? t1 : mk; }
#pragma unroll
            for (int o = 1; o < 64; o <<= 1) { const unsigned y = (unsigned)__shfl_xor((int)mk, o); mk = y > mk ? y : mk; }
            if (lane == 0) kmx[((it_ + 1) & 1) * 8 + wid] = mk; }
        __syncthreads();
    }

    const float lt = l + __shfl_xor(l, 32);
    write_out_z(o0, o1, lt > 0.f ? 1.f / lt : 0.f, zpre, MIX + (rb + wq0) * D + 64 * h, D, (float*)(sm + L_TACC) + wid * 2048, lane);
}

DI void sb_unit(const bf16* PR, bf16* MIX, char* sm, int b, int h, int qb) {
    int tid_ = threadIdx.x; asm volatile("" : "+v"(tid_)); const int tid = tid_, lane = tid & 63, r32 = lane & 31, hi = lane >> 5, wid = __builtin_amdgcn_readfirstlane(tid >> 6);
    volatile LAS unsigned* misc = (volatile LAS unsigned*)(sm + L_MISC);
    const int q0 = 256 * qb; const size_t rb = (size_t)b * S;
    const int t = q0 + 32 * wid + r32, wq0 = q0 + 32 * wid;
    bf16x8 qr[5];
#pragma unroll
    for (int d0 = 0; d0 < 4; ++d0) qr[d0] = *(const bf16x8*)(PR + (rb + t) * NP + C_SQ + 64 * h + 16 * d0 + 8 * hi);
    qr[4] = (bf16x8){0, 0, 0, 0, 0, 0, 0, 0};
    const bf16* Kb = PR + rb * NP + C_SK + 64 * h; const bf16* Vb = PR + rb * NP + C_SV + 64 * h;
    float R = 1.f; f32x16 o0, o1;
#pragma unroll
    for (int i = 0; i < 16; ++i) { o0[i] = 0.f; o1[i] = 0.f; }
    unsigned z_ = 0u; asm volatile("" : "+v"(z_)); u32x4 kr, vr, ar = {z_, z_, z_, z_};
    const int nt = 4 * qb + 4;
    u32x4 zpre[4];
    { const bf16* zrow0 = PR + (rb + wq0) * NP + C_SZ + 64 * h;
#pragma unroll
      for (int j = 0; j < 4; ++j) zpre[j] = *(const u32x4*)(zrow0 + (size_t)((lane >> 3) + 8 * j) * NP + 8 * (lane & 7)); }
    { const int kt = nt - 1; kv_issue(Kb + (size_t)(64 * kt) * NP, Vb + (size_t)(64 * kt) * NP, NP, wid, lane, kr, vr); }
    kv_commit(sm, tid, wid, lane, kr, vr, ar); __syncthreads();
    for (int it = 0; it < nt; ++it) {
        const int kt = nt - 1 - it; const char* cb = sm + (it & 1) * STG; const bool more = it + 1 < nt;
        if (more) kv_issue(Kb + (size_t)(64 * (kt - 1)) * NP, Vb + (size_t)(64 * (kt - 1)) * NP, NP, wid, lane, kr, vr);
        bool wdone = false;
        if (64 * kt <= wq0 + 30) {
            if (__any(R >= 1e-30f)) {
                f32x16 x0, x1; qk_tile(cb, qr, r32, hi, x0, x1); bf16x8 vf[8]; v_load(cb + 9216, lane, hi, vf);
                if (64 * kt + 63 >= wq0) mask_tile(x0, x1, 0, t - 1 - 64 * kt, hi);
                sb_tile(x0, x1, R, hi);
                pv_tile(vf, x0, x1, o0, o1);
            }
            wdone = !__any(R >= 1e-30f);
        }
        if (lane == 0) misc[2 + (it & 1) * 8 + wid] = wdone ? 1u : 0u;
        if (more) kv_commit(sm + ((it + 1) & 1) * STG, tid, wid, lane, kr, vr, ar);
        __syncthreads();
        unsigned alld = 1u;
#pragma unroll
        for (int w = 0; w < 8; ++w) alld &= misc[2 + (it & 1) * 8 + w];
        if (alld) break;
    }
    __syncthreads();
    write_out_z(o0, o1, 1.f, zpre, MIX + (rb + wq0) * D + 384 + 64 * h, D, (float*)(sm + L_TACC) + wid * 2048, lane);
}

DI void cmp_unit(const bf16* PR, const bf16* W1T, const bf16* W2T, const float* PB, bf16* OUT, int col, char* sm, int b, int ntile) {
    int tid_ = threadIdx.x; asm volatile("" : "+v"(tid_)); const int tid = tid_, lane = tid & 63, wid = __builtin_amdgcn_readfirstlane(tid >> 6);
    float* red = (float*)(sm + L_RED); float* hid = (float*)(sm + L_HID);
    const int row = lane & 15, kq = lane >> 4;
    const int n = 16 * ntile + row, nc = n < 126 ? n : 126;
    f32x4 acc[4];
#pragma unroll
    for (int e = 0; e < 4; ++e) acc[e] = (f32x4){0.f, 0.f, 0.f, 0.f};
#pragma unroll
    for (int half = 0; half < 2; ++half) {
        bf16x8 af[4], bfr[4][4];
#pragma unroll
        for (int s4 = 0; s4 < 4; ++s4) {
            const int f0 = 256 * wid + 32 * (4 * half + s4) + 8 * kq, tl = f0 >> 6, d = f0 & 63;
            af[s4] = *(const bf16x8*)(PR + ((size_t)b * S + 16 * nc + tl) * NP + col + d);
#pragma unroll
            for (int et = 0; et < 4; ++et) bfr[s4][et] = *(const bf16x8*)(W1T + (size_t)(16 * et + row) * 2048 + f0);
        }
#pragma unroll
        for (int s4 = 0; s4 < 4; ++s4)
#pragma unroll
            for (int et = 0; et < 4; ++et) acc[et] = MFMA16(af[s4], bfr[s4][et], acc[et]);
    }
#pragma unroll
    for (int et = 0; et < 4; ++et)
#pragma unroll
        for (int j = 0; j < 4; ++j) red[(wid * 16 + kq * 4 + j) * 64 + 16 * et + row] = acc[et][j];
    __syncthreads();
    for (int idx = tid; idx < 1024; idx += 512) { float s = 0.f;
#pragma unroll
        for (int w = 0; w < 8; ++w) s += red[w * 1024 + idx];
        s += PB[idx & 63]; hid[idx] = silu_f(s); }
    __syncthreads();
    if (wid < 4) {
        f32x4 c = (f32x4){0.f, 0.f, 0.f, 0.f};
#pragma unroll
        for (int step = 0; step < 2; ++step) {
            const float* hp = hid + row * 64 + 32 * step + 8 * kq;
            u32x4 aw; aw.x = cvtpk(hp[0], hp[1]); aw.y = cvtpk(hp[2], hp[3]); aw.z = cvtpk(hp[4], hp[5]); aw.w = cvtpk(hp[6], hp[7]);
            const bf16x8 bb = *(const bf16x8*)(W2T + (size_t)(16 * wid + row) * 64 + 32 * step + 8 * kq);
            c = MFMA16(__builtin_bit_cast(bf16x8, aw), bb, c);
        }
#pragma unroll
        for (int j = 0; j < 4; ++j) { const int nn = 16 * ntile + kq * 4 + j; OUT[((size_t)b * 128 + nn) * 64 + 16 * wid + row] = (bf16)(nn <= 126 ? f2bf(c[j]) : 0u); }
    }
    __syncthreads();
}

DI int nth_set_desc(unsigned m, int n) { for (int i = 0; i < n; ++i) m &= ~(1u << (31 - __clz((int)m))); return 31 - __clz((int)m); }
DI int nth_set(unsigned m, int n) { for (int i = 0; i < n; ++i) m &= m - 1u; return __ffs((int)m) - 1; }
DI void nsa_unit(const bf16* PR, const float* AUX, const bf16* KC, const bf16* VC, bf16* MIX, char* sm, int b, int qb) {
    int tid_ = threadIdx.x; asm volatile("" : "+v"(tid_)); const int tid = tid_, lane = tid & 63, r32 = lane & 31, hi = lane >> 5, wid = __builtin_amdgcn_readfirstlane(tid >> 6);
    float* impL = (float*)(sm + L_IMP); volatile LAS unsigned* selm = (volatile LAS unsigned*)(sm + L_SELM); volatile LAS unsigned* misc = (volatile LAS unsigned*)(sm + L_MISC);
    const int g = wid >> 1, ql = 32 * (wid & 1) + r32, cur = qb, t = 64 * qb + ql; const size_t rb = (size_t)b * S, row = rb + t;
    bf16x8 qr[5];
#pragma unroll
    for (int d0 = 0; d0 < 4; ++d0) qr[d0] = *(const bf16x8*)(PR + row * NP + C_NQ + 64 * g + 16 * d0 + 8 * hi);
    { const short s8 = hi ? (short)0 : (short)f2bf(exp2f((float)(1 - 2 * g))); qr[4] = (bf16x8){s8, s8, 0, 0, 0, 0, 0, 0}; }
    const float g0 = sigm_f(AUX[row * 32 + 6 + 3 * g]), g1 = sigm_f(AUX[row * 32 + 7 + 3 * g]), g2 = sigm_f(AUX[row * 32 + 8 + 3 * g]);
    f32x16 o0, o1;
    float* tacc = (float*)(sm + L_TACC) + wid * 2048 + lane;
    unsigned z_ = 0u; asm volatile("" : "+v"(z_)); u32x4 kr, vr, ar = {z_, z_, z_, z_};
    const int ntc = (4 * qb + 2) / 64 + 1, khc = (t - 31) >> 4;
    const bf16* KCb = KC + (size_t)b * 128 * 64; const bf16* VCb = VC + (size_t)b * 128 * 64;
    float m = MINIT, l = 0.f;
    {
        u32x4 kr2, vr2, ar2;
        kv_issue(KCb, VCb, 64, wid, lane, kr, vr); if (wid == 0) ar = pos_aug(16 * lane + 31);
        if (ntc > 1) { kv_issue(KCb + 64 * 64, VCb + 64 * 64, 64, wid, lane, kr2, vr2); if (wid == 0) ar2 = pos_aug(16 * (64 + lane) + 31); }
        kv_commit(sm, tid, wid, lane, kr, vr, ar);
        if (ntc > 1) kv_commit(sm + STG, tid, wid, lane, kr2, vr2, ar2);
        __syncthreads();
        for (int it = 0; it < ntc; ++it) { const char* cb = sm + it * STG; f32x16 x0, x1; qk_tile(cb, qr, r32, hi, x0, x1); mask_tile(x0, x1, 0, khc - 64 * it, hi); smx_stats(x0, x1, m, l); }
        const float lt = l + __shfl_xor(l, 32); const float invl = lt > 0.f ? 1.f / lt : 0.f;
        float carry = 0.f;
#pragma unroll
        for (int i = 0; i < 16; ++i) { o0[i] = 0.f; o1[i] = 0.f; }
        for (int it = 0; it < ntc; ++it) { const char* cb = sm + it * STG;
              f32x16 x0, x1; qk_tile(cb, qr, r32, hi, x0, x1); bf16x8 vf[8]; v_load(cb + 9216, lane, hi, vf); mask_tile(x0, x1, 0, khc - 64 * it, hi);
#pragma unroll
              for (int i = 0; i < 16; ++i) { x0[i] = ex2(fmaf(x0[i], C2, -m)) * invl; x1[i] = ex2(fmaf(x1[i], C2, -m)) * invl; }
              float qs[8], lastv[8], rcv[8];
#pragma unroll
              for (int gq = 0; gq < 4; ++gq) { qs[gq] = (x0[4 * gq] + x0[4 * gq + 1]) + (x0[4 * gq + 2] + x0[4 * gq + 3]); lastv[gq] = x0[4 * gq + 3];
                                               qs[4 + gq] = (x1[4 * gq] + x1[4 * gq + 1]) + (x1[4 * gq + 2] + x1[4 * gq + 3]); lastv[4 + gq] = x1[4 * gq + 3]; }
#pragma unroll
              for (int gq = 0; gq < 8; ++gq) rcv[gq] = __shfl_xor(lastv[gq], 32);
#pragma unroll
              for (int gq = 0; gq < 8; ++gq) {
                  const float add0 = gq > 0 ? rcv[gq - 1] : carry;
                  const float val = qs[gq] + (hi ? rcv[gq] : add0);
                  impL[(g * 64 + ql) * 33 + 16 * it + 2 * gq + hi] = val;
              }
              carry = rcv[7];
              pv_tile(vf, x0, x1, o0, o1); }
        __syncthreads();
#pragma unroll
        for (int i = 0; i < 16; ++i) { tacc[i * 64] = g0 * o0[i]; tacc[(16 + i) * 64] = g0 * o1[i]; }
    }
    if (wid == 0) {
        const unsigned forced = 1u | (1u << cur) | (cur >= 1 ? (1u << (cur - 1)) : 0u);
        unsigned selbits = forced; const int ncand = cur - 2;
        if (ncand > 0) {
            const int nfree = 8 - __popc(forced);
            if (ncand <= nfree) selbits |= ((1u << (cur - 1)) - 2u);
            else {
                float* rowp = impL + lane * 33;
                for (int j = 1; j <= cur - 2; ++j) rowp[j] = ((rowp[j] + impL[(64 + lane) * 33 + j]) + impL[(128 + lane) * 33 + j]) + impL[(192 + lane) * 33 + j];
                for (int r = 0; r < nfree; ++r) { float best = -1.f; int bj = 1;
                    for (int j = 1; j <= cur - 2; ++j) { const float v = rowp[j]; if (v > best) { best = v; bj = j; } }
                    selbits |= 1u << bj; rowp[bj] = -2.f; }
            }
        }
        selm[lane] = selbits;
        unsigned any = selbits;
#pragma unroll
        for (int o = 1; o < 64; o <<= 1) any |= (unsigned)__shfl_xor((int)any, o);
        if (lane == 0) misc[1] = any;
    }
    __syncthreads();
    {
        const unsigned anym = misc[1] & ((2u << cur) - 1u); const unsigned mysel = selm[ql];
        const int nts = __popc(anym);
        const bf16* Kb = PR + rb * NP + C_NKS; const bf16* Vb = PR + rb * NP + C_NVS;
        m = MINIT; l = 0.f;
#pragma unroll
        for (int i = 0; i < 16; ++i) { o0[i] = 0.f; o1[i] = 0.f; }
        for (int it_ = -1, nt_ = (nts); it_ < nt_; ++it_) {
        const bool more_ = it_ + 1 < nt_;
        if (more_) { const int it = it_ + 1; { const int j = nth_set_desc(anym, it); kv_issue(Kb + (size_t)(64 * j) * NP, Vb + (size_t)(64 * j) * NP, NP, wid, lane, kr, vr); if (wid == 0) ar = pos_aug(64 * j + lane); } }
        if (it_ >= 0) { const int it = it_; const char* cb = sm + (it & 1) * STG; { const int j = nth_set_desc(anym, it);
              f32x16 x0, x1; qk_tile(cb, qr, r32, hi, x0, x1); bf16x8 vf[8]; v_load(cb + 9216, lane, hi, vf);
              const bool selj = ((mysel >> j) & 1u) != 0u;
              if (j == cur) mask_tile(x0, x1, 0, selj ? t - 64 * j : -1, hi);
              smx_tile_sel(x0, x1, m, l, o0, o1, selj || j == cur);
              pv_tile(vf, x0, x1, o0, o1); } }
        if (more_) kv_commit(sm + ((it_ + 1) & 1) * STG, tid, wid, lane, kr, vr, ar);
        __syncthreads();
    }

        const float lt = l + __shfl_xor(l, 32); const float sc = lt > 0.f ? g1 / lt : 0.f;
#pragma unroll
        for (int i = 0; i < 16; ++i) { tacc[i * 64] += sc * o0[i]; tacc[(16 + i) * 64] += sc * o1[i]; }
    }
    u32x4 zpre[2];
    {
        const int j0 = cur >= 8 ? cur - 8 : 0;
        const bf16* Kb = PR + rb * NP + C_NKW; const bf16* Vb = PR + rb * NP + C_NVW;
        m = MINIT; l = 0.f;
#pragma unroll
        for (int i = 0; i < 16; ++i) { o0[i] = 0.f; o1[i] = 0.f; }
        for (int it_ = -1, nt_ = (cur - j0 + 1); it_ < nt_; ++it_) {
        const bool more_ = it_ + 1 < nt_;
        if (!more_) { const bf16* zrow0 = PR + (rb + 64 * qb + 32 * (wid & 1)) * NP + C_NZ + 64 * g;
#pragma unroll
            for (int j = 0; j < 2; ++j) zpre[j] = *(const u32x4*)(zrow0 + (size_t)((lane >> 3) + 8 * j) * NP + 8 * (lane & 7)); }
        if (more_) { const int it = it_ + 1; { const int j = cur - it; kv_issue(Kb + (size_t)(64 * j) * NP, Vb + (size_t)(64 * j) * NP, NP, wid, lane, kr, vr); if (wid == 0) ar = pos_aug(64 * j + lane); } }
        if (it_ >= 0) { const int it = it_; const char* cb = sm + (it & 1) * STG; { const int j = cur - it;
              f32x16 x0, x1; qk_tile(cb, qr, r32, hi, x0, x1); bf16x8 vf[8]; v_load(cb + 9216, lane, hi, vf);
              if (j == cur || j == cur - 8) mask_tile(x0, x1, t - 511 - 64 * j, t - 64 * j, hi);
              smx_tile(x0, x1, m, l, o0, o1);
              pv_tile(vf, x0, x1, o0, o1); } }
        if (more_) kv_commit(sm + ((it_ + 1) & 1) * STG, tid, wid, lane, kr, vr, ar);
        __syncthreads();
    }

        const float lt = l + __shfl_xor(l, 32); const float sc = lt > 0.f ? g2 / lt : 0.f;
#pragma unroll
        for (int i = 0; i < 16; ++i) { o0[i] = tacc[i * 64] + sc * o0[i]; o1[i] = tacc[(16 + i) * 64] + sc * o1[i]; }
    }
    { const size_t r0 = rb + 64 * qb + 32 * (wid & 1);
      write_out_zh(o0, o1, 1.f, zpre, PR + r0 * NP + C_NZ + 64 * g, NP, MIX + r0 * D + 768 + 64 * g, D, (float*)(sm + L_TACC) + wid * 2048, lane); }
}

struct EpiProj {
    static constexpr bool PERM = true, AFTER_DRAIN = false;
    bf16* O; float* aux;
    __device__ __forceinline__ void operator()(const f32x4 (&acc)[2][2][4][2], const pg8::Unit& u, int wr, int wc, int fr, int fq) const {
        const int row0 = u.pm * 256 + wr * 64 + fr, col0 = u.pn * 256 + wc * 32 + 8 * fq;
#pragma unroll
        for (int ai = 0; ai < 2; ++ai)
#pragma unroll
            for (int m = 0; m < 4; ++m) { bf16* rowp = O + (size_t)(row0 + ai * 128 + m * 16) * NP + col0;
#pragma unroll
                for (int bj = 0; bj < 2; ++bj) { const f32x4 v0 = acc[ai][bj][m][0], v1 = acc[ai][bj][m][1];
                    u32x4 w; w.x = cvtpk(v0[0], v0[1]); w.y = cvtpk(v0[2], v0[3]); w.z = cvtpk(v1[0], v1[1]); w.w = cvtpk(v1[2], v1[3]);
                    *(u32x4*)(rowp + bj * 128) = w; } }
        if (u.pn == 15 && wc == 0) {
#pragma unroll
            for (int ai = 0; ai < 2; ++ai)
#pragma unroll
                for (int m = 0; m < 4; ++m) { float* ap = aux + (size_t)(row0 + ai * 128 + m * 16) * 32 + 8 * fq;
                    *(f32x4*)ap = acc[ai][1][m][0]; *(f32x4*)(ap + 4) = acc[ai][1][m][1]; }
        }
    }
};
struct EpiOut {
    static constexpr bool PERM = true, AFTER_DRAIN = false;
    const float* X; float* O;
    __device__ __forceinline__ void operator()(const f32x4 (&acc)[2][2][4][2], const pg8::Unit& u, int wr, int wc, int fr, int fq) const {
        const int row0 = u.pm * 256 + wr * 64 + fr, col0 = u.pn * 256 + wc * 32 + 8 * fq;
#pragma unroll
        for (int ai = 0; ai < 2; ++ai)
#pragma unroll
            for (int m = 0; m < 4; ++m)
#pragma unroll
                for (int bj = 0; bj < 2; ++bj) { const size_t idx = (size_t)(row0 + ai * 128 + m * 16) * D + col0 + bj * 128;
                    const f32x4 a = *(const f32x4*)(X + idx), c = *(const f32x4*)(X + idx + 4);
                    *(f32x4*)(O + idx) = a + acc[ai][bj][m][0]; *(f32x4*)(O + idx + 4) = c + acc[ai][bj][m][1]; }
    }
};

DI int src_col(int np) {
    if (np < 1152) return np;
    if (np < 3712) return np + 6;
    if (np < 3968) return np + 18;
    if (np < 3974) return 1152 + (np - 3968);
    if (np < 3986) return 3718 + (np - 3974);
    return -1;
}
DI void transpose_item(const float* W, int K, int N, bf16* WT, int nblk, bool perm, float* scr, int item, int lane) {
    const int kb = item / nblk, nb = item % nblk, k0 = 64 * kb, n0 = 32 * nb;
    const int np = n0 + (lane & 31); const int sc = perm ? src_col(np) : np;
    float wv[32];
#pragma unroll
    for (int i = 0; i < 32; ++i) { const int kk = 2 * i + (lane >> 5); wv[i] = sc >= 0 ? W[(size_t)(k0 + kk) * N + sc] : 0.f; }
#pragma unroll
    for (int i = 0; i < 32; ++i) { const int kk = 2 * i + (lane >> 5); scr[kk * 33 + (lane & 31)] = wv[i]; }
    __builtin_amdgcn_s_waitcnt(0); __builtin_amdgcn_wave_barrier();
    const int c = lane & 7;
#pragma unroll
    for (int j = 0; j < 4; ++j) { const int n = (lane >> 3) + 8 * j; const float* s = scr + (8 * c) * 33 + n;
        u32x4 o; o.x = cvtpk(s[0 * 33], s[1 * 33]); o.y = cvtpk(s[2 * 33], s[3 * 33]); o.z = cvtpk(s[4 * 33], s[5 * 33]); o.w = cvtpk(s[6 * 33], s[7 * 33]);
        *(u32x4*)(WT + (size_t)(n0 + n) * K + k0 + 8 * c) = o; }
    __builtin_amdgcn_s_waitcnt(0); __builtin_amdgcn_wave_barrier();
}
DI void norm_row_bf16(const float* xrow, const float* gw, bf16* orow, int lane) {
    f32x4 v[4]; float s = 0.f;
#pragma unroll
    for (int j = 0; j < 4; ++j) { v[j] = *(const f32x4*)(xrow + 4 * lane + 256 * j); s += (v[j].x * v[j].x + v[j].y * v[j].y) + (v[j].z * v[j].z + v[j].w * v[j].w); }
    const float rs = 1.f / sqrtf(wave_sum(s) * (1.f / D) + 1e-6f);
#pragma unroll
    for (int j = 0; j < 4; ++j) { const f32x4 gg = *(const f32x4*)(gw + 4 * lane + 256 * j);
        u32x2 w; w.x = cvtpk(v[j].x * rs * gg.x, v[j].y * rs * gg.y); w.y = cvtpk(v[j].z * rs * gg.z, v[j].w * rs * gg.w);
        *(u32x2*)(orow + 4 * lane + 256 * j) = w; }
}
DI void norm_row_f32(float* xrow, const float* gw, int lane) {
    f32x4 v[4]; float s = 0.f;
#pragma unroll
    for (int j = 0; j < 4; ++j) { v[j] = *(const f32x4*)(xrow + 4 * lane + 256 * j); s += (v[j].x * v[j].x + v[j].y * v[j].y) + (v[j].z * v[j].z + v[j].w * v[j].w); }
    const float rs = 1.f / sqrtf(wave_sum(s) * (1.f / D) + 1e-6f);
#pragma unroll
    for (int j = 0; j < 4; ++j) { const f32x4 gg = *(const f32x4*)(gw + 4 * lane + 256 * j);
        *(f32x4*)(xrow + 4 * lane + 256 * j) = (f32x4){v[j].x * rs * gg.x, v[j].y * rs * gg.y, v[j].z * rs * gg.z, v[j].w * rs * gg.w}; }
}

template <bool BF> DI void norm_rows4(float* src, const float* gw, bf16* dstb, int r0, int stride, int lane) {
    f32x4 v[4][4];
#pragma unroll
    for (int k = 0; k < 4; ++k) { const int r = r0 + k * stride;
#pragma unroll
        for (int j = 0; j < 4; ++j) v[k][j] = r < M ? *(const f32x4*)(src + (size_t)r * D + 4 * lane + 256 * j) : (f32x4){0.f, 0.f, 0.f, 0.f}; }
    f32x4 gg[4];
#pragma unroll
    for (int j = 0; j < 4; ++j) gg[j] = *(const f32x4*)(gw + 4 * lane + 256 * j);
#pragma unroll
    for (int k = 0; k < 4; ++k) { const int r = r0 + k * stride; float s = 0.f;
#pragma unroll
        for (int j = 0; j < 4; ++j) s += (v[k][j].x * v[k][j].x + v[k][j].y * v[k][j].y) + (v[k][j].z * v[k][j].z + v[k][j].w * v[k][j].w);
        const float rs = 1.f / sqrtf(wave_sum(s) * (1.f / D) + 1e-6f);
        if (r < M) {
#pragma unroll
            for (int j = 0; j < 4; ++j) {
                const f32x4 y = (f32x4){v[k][j].x * rs * gg[j].x, v[k][j].y * rs * gg[j].y, v[k][j].z * rs * gg[j].z, v[k][j].w * rs * gg[j].w};
                if (BF) { u32x2 w; w.x = cvtpk(y.x, y.y); w.y = cvtpk(y.z, y.w); *(u32x2*)(dstb + (size_t)r * D + 4 * lane + 256 * j) = w; }
                else *(f32x4*)(src + (size_t)r * D + 4 * lane + 256 * j) = y;
            }
        }
    }
}

struct Params { const float *x, *norm_g, *w_in, *b_f, *pos_k, *w1_k, *w2_k, *pos_v, *w1_v, *w2_v, *w_out, *final_g; float* out; unsigned char* ws; };

DI int next_unit(unsigned* ctr, char* sm) {
    volatile LAS int* slot = (volatile LAS int*)(sm + L_MISC);
    __syncthreads();
    if (threadIdx.x == 0) *slot = (int)atomicAdd(ctr, 1u);
    __syncthreads();
    return *slot;
}

#define XB_TMO      128
#define XB_XCNT(j)  (256  + 64 * (j))
#define XB_XSUB(j)  (1280 + 64 * (j))
#define XB_XGEN(j)  (2304 + 64 * (j))
#define XB_TOP      3328
#define XB_TOPGEN   3392
#define XCD_BAR_WORDS 3456
#define XB_SPIN_CAP (1u << 18)

__device__ __forceinline__ unsigned xb_ld(unsigned* p)              { return __hip_atomic_load(p, __ATOMIC_RELAXED, __HIP_MEMORY_SCOPE_AGENT); }
__device__ __forceinline__ unsigned xb_add(unsigned* p, unsigned v) { return __hip_atomic_fetch_add(p, v, __ATOMIC_RELAXED, __HIP_MEMORY_SCOPE_AGENT); }
__device__ __forceinline__ unsigned xb_xcc_id() { return (unsigned)__builtin_amdgcn_s_getreg((3 << 11) | 20) & 0xFu; }
#define XB_SPIN(cond, bar) do { unsigned _sp = 0; while (cond) { __builtin_amdgcn_s_sleep(1); \
    if ((++_sp & 255u) == 0u) { if (xb_ld(&(bar)[XB_TMO])) break; if (_sp > XB_SPIN_CAP) { atomicAdd(&(bar)[XB_TMO], 1u); break; } } } } while (0)

struct XcdBarrier {
    unsigned* bar; unsigned x;
    volatile LAS unsigned* st;
};

__device__ __forceinline__ XcdBarrier xcd_barrier_post(unsigned* bar, volatile LAS unsigned* st) {
    XcdBarrier b; b.bar = bar; b.x = xb_xcc_id(); b.st = st;
    if (threadIdx.x == 0) (void)xb_add(&bar[XB_XCNT(b.x)], 1u);
    return b;
}
__device__ __forceinline__ void xcd_barrier_complete(unsigned* bar, unsigned x, unsigned& nloc, unsigned& nx) {
    const unsigned G = gridDim.x * gridDim.y * gridDim.z;
    unsigned sum, cnt, mine, sp = 0u;
    for (;;) {
        sum = 0u; cnt = 0u; mine = 0u;
#pragma unroll
        for (unsigned j = 0; j < 16; ++j) { const unsigned c = xb_ld(&bar[XB_XCNT(j)]); sum += c; cnt += (c > 0u) ? 1u : 0u; mine = (j == x) ? c : mine; }
        if (sum == G) break;
        __builtin_amdgcn_s_sleep(1);
        if ((++sp & 255u) == 0u) { if (xb_ld(&bar[XB_TMO])) break; if (sp > XB_SPIN_CAP) { atomicAdd(&bar[XB_TMO], 1u); break; } }
    }
    nloc = mine > 0u ? mine : 1u; nx = cnt > 0u ? cnt : 1u;
}

__device__ __forceinline__ void xcd_barrier(const XcdBarrier& b) {
    asm volatile("s_waitcnt vmcnt(0)" ::: "memory");
    __syncthreads();
    if (threadIdx.x == 0) {
        unsigned* bar = b.bar;
        __builtin_amdgcn_s_waitcnt(0);
        unsigned nloc = b.st[0], nx = b.st[1];
        if (nloc == 0u) { xcd_barrier_complete(bar, b.x, nloc, nx); b.st[0] = nloc; b.st[1] = nx; }
        const unsigned old = xb_add(&bar[XB_XSUB(b.x)], 1u);
        const unsigned gen = old / nloc;
        if (old + 1u == (gen + 1u) * nloc) {
            __builtin_amdgcn_fence(__ATOMIC_RELEASE, "agent");
            asm volatile("s_waitcnt vmcnt(0)" ::: "memory");
            const unsigned og = xb_add(&bar[XB_TOP], 1u);
            const unsigned tg = og / nx;
            if (og + 1u == (tg + 1u) * nx) xb_add(&bar[XB_TOPGEN], 1u);
            else XB_SPIN(xb_ld(&bar[XB_TOPGEN]) == tg, bar);
            __builtin_amdgcn_fence(__ATOMIC_ACQUIRE, "agent");
            xb_add(&bar[XB_XGEN(b.x)], 1u);
            asm volatile("s_waitcnt vmcnt(0)" ::: "memory");
        } else {
            XB_SPIN(xb_ld(&bar[XB_XGEN(b.x)]) == gen, bar);
            __builtin_amdgcn_fence(__ATOMIC_ACQUIRE, "agent");
            asm volatile("s_waitcnt vmcnt(0)" ::: "memory");
        }
    }
    __syncthreads();
}

__global__ void __launch_bounds__(512, 2) mega_fwd(Params p) {
    extern __shared__ __attribute__((aligned(16))) unsigned char smem[];
    cg::grid_group grid = cg::this_grid();
    char* sm = (char*)smem;
    int tid_ = threadIdx.x; asm volatile("" : "+v"(tid_)); const int tid = tid_, lane = tid & 63, wid = __builtin_amdgcn_readfirstlane(tid >> 6);
    const int G = gridDim.x, gw = blockIdx.x * 8 + wid, NGW = G * 8;
    unsigned char* ws = p.ws;
    unsigned* ctl = (unsigned*)(ws + WS_CTL);
    volatile LAS unsigned* XBW = (volatile LAS unsigned*)(sm + L_XB);
    if (threadIdx.x == 0) { XBW[0] = 0u; XBW[1] = 0u; }
    __syncthreads();
    const XcdBarrier xbar = xcd_barrier_post(ctl + 1024, XBW);
    bf16* WTIN = (bf16*)(ws + WS_WTIN); bf16* WTOUT = (bf16*)(ws + WS_WTOUT); bf16* W1T = (bf16*)(ws + WS_W1T); bf16* W2T = (bf16*)(ws + WS_W2T);
    float* PB = (float*)(ws + WS_PB); bf16* KC = (bf16*)(ws + WS_KC); bf16* VC = (bf16*)(ws + WS_VC); float* AUX = (float*)(ws + WS_AUX);
    bf16* H = (bf16*)(ws + WS_H); bf16* PROJ = (bf16*)(ws + WS_PROJ);

    {
        float* scr = (float*)(sm + wid * 16384);
        constexpr int I_IN = 16 * 128, I_OUT = 16 * 32, I_W1 = 32 * 2, I_W2 = 2;
        constexpr int NITEMS = 2 * I_IN + 2 * I_OUT + 4 * I_W1 + 4 * I_W2;
        for (int it = gw; it < NITEMS; it += NGW) {
            int r = it;
            if (r < 2 * I_IN) { const int l = r / I_IN; transpose_item(p.w_in + (size_t)l * D * DIN, D, DIN, WTIN + (size_t)l * NP * D, 128, true, scr, r % I_IN, lane); continue; } r -= 2 * I_IN;
            if (r < 2 * I_OUT) { const int l = r / I_OUT; transpose_item(p.w_out + (size_t)l * D * D, D, D, WTOUT + (size_t)l * D * D, 32, false, scr, r % I_OUT, lane); continue; } r -= 2 * I_OUT;
            if (r < 4 * I_W1) { const int q = r / I_W1, l = q >> 1, kv = q & 1; transpose_item((kv ? p.w1_v : p.w1_k) + (size_t)l * 2048 * 64, 2048, 64, W1T + (size_t)q * 64 * 2048, 2, false, scr, r % I_W1, lane); continue; } r -= 4 * I_W1;
            { const int q = r / I_W2, l = q >> 1, kv = q & 1; transpose_item((kv ? p.w2_v : p.w2_k) + (size_t)l * 64 * 64, 64, 64, W2T + (size_t)q * 64 * 64, 2, false, scr, r % I_W2, lane); }
        }
        for (int it = gw; it < 256; it += NGW) {
            const int q = it >> 6, e = it & 63, l = q >> 1, kv = q & 1;
            const float* pos = (kv ? p.pos_v : p.pos_k) + (size_t)l * 2048; const float* w1 = (kv ? p.w1_v : p.w1_k) + (size_t)l * 2048 * 64;
            float s = 0.f;
            for (int f = lane; f < 2048; f += 64) s += pos[f] * w1[(size_t)f * 64 + e];
            s = wave_sum(s);
            if (lane == 0) PB[it] = s;
        }
        for (int r = gw; r < M; r += 4 * NGW) norm_rows4<true>(const_cast<float*>(p.x), p.norm_g, H, r, NGW, lane);
    }
    if (gridDim.y == 0x7fffu) grid.sync();
    xcd_barrier(XcdBarrier{ctl + 1024, xb_xcc_id(), (volatile LAS unsigned*)(sm + L_XB)});

    for (int l = 0; l < 2; ++l) {
        for (int rep1 = 0; rep1 < REP_P1; ++rep1) {
            pg8::Gemm g{H, WTIN + (size_t)l * NP * D, M, NP, D}; pg8::StaticOrder So; So.init(M, NP, G, (int)blockIdx.x);
            EpiProj E{PROJ, AUX};
            pg8::gemm_phase<EpiProj, pg8::StaticOrder, true, true>((PG8_LAS unsigned char*)smem, g, So, E);
        }
        xcd_barrier(XcdBarrier{ctl + 1024, xb_xcc_id(), (volatile LAS unsigned*)(sm + L_XB)});
        if (__builtin_amdgcn_readfirstlane((int)(threadIdx.x >> 6)) >= 4) __builtin_amdgcn_s_setprio(1);
        for (int u = next_unit(ctl + 2 * l, sm); u < 2816;) {
            int nxt_ = 0; if (threadIdx.x == 0) nxt_ = (int)atomicAdd(ctl + 2 * l, 1u);
            if (u < 768) { const int k = u / 192, bh = u % 192;
                fox_unit(PROJ, AUX, p.b_f + 6 * l, H, sm, bh / 6, bh % 6, 7 - k, true); fox_unit(PROJ, AUX, p.b_f + 6 * l, H, sm, bh / 6, bh % 6, k, false); }
            else if (u < 2304) { const int v = u - 768; const int qb = 7 - v / 192, bh = v % 192; sb_unit(PROJ, H, sm, bh / 6, bh % 6, qb); }
            else { const int v = u - 2304; const int b = v >> 4, kv = (v >> 3) & 1, nt = v & 7; const int q = 2 * l + kv;
                   cmp_unit(PROJ, W1T + (size_t)q * 64 * 2048, W2T + (size_t)q * 64 * 64, PB + q * 64, kv ? VC : KC, kv ? C_NVC : C_NKC, sm, b, nt); }
            { volatile LAS int* slot = (volatile LAS int*)(sm + L_MISC); __syncthreads(); if (threadIdx.x == 0) *slot = nxt_; __syncthreads(); u = *slot; }
        }
        xcd_barrier(XcdBarrier{ctl + 1024, xb_xcc_id(), (volatile LAS unsigned*)(sm + L_XB)});
        for (int u = next_unit(ctl + 2 * l + 1, sm); u < 1024;) {
            int nxt_ = 0; if (threadIdx.x == 0) nxt_ = (int)atomicAdd(ctl + 2 * l + 1, 1u);
            nsa_unit(PROJ, AUX, KC, VC, H, sm, u & 31, 31 - (u >> 5));
            { volatile LAS int* slot = (volatile LAS int*)(sm + L_MISC); __syncthreads(); if (threadIdx.x == 0) *slot = nxt_; __syncthreads(); u = *slot; }
        }
        xcd_barrier(XcdBarrier{ctl + 1024, xb_xcc_id(), (volatile LAS unsigned*)(sm + L_XB)});
        __builtin_amdgcn_s_setprio(0);
        {
            pg8::Gemm g{H, WTOUT + (size_t)l * D * D, M, D, D}; pg8::StaticOrder So; So.init(M, D, G, (int)blockIdx.x);
            EpiOut E{l == 0 ? p.x : p.out, p.out};
            pg8::gemm_phase<EpiOut, pg8::StaticOrder, true, true>((PG8_LAS unsigned char*)smem, g, So, E);
        }
        xcd_barrier(XcdBarrier{ctl + 1024, xb_xcc_id(), (volatile LAS unsigned*)(sm + L_XB)});
        { int t5 = threadIdx.x; asm volatile("" : "+v"(t5)); const int lane5 = t5 & 63, gw5 = blockIdx.x * 8 + __builtin_amdgcn_readfirstlane(t5 >> 6);
        if (l == 0) { for (int r = gw5; r < M; r += 4 * NGW) norm_rows4<true>(p.out, p.norm_g + D, H, r, NGW, lane5); xcd_barrier(XcdBarrier{ctl + 1024, xb_xcc_id(), (volatile LAS unsigned*)(sm + L_XB)}); }
        else { for (int r = gw5; r < M; r += 4 * NGW) norm_rows4<false>(p.out, p.final_g, nullptr, r, NGW, lane5); } }
    }
}

extern "C" void kernel_launch(void* const* d_in, const int* in_sizes, int n_in, void* d_out, int out_size, void* d_ws, size_t ws_size, hipStream_t stream) {
    static int grid = 0;
    if (grid == 0) {
        if (n_in != 12 || out_size != M * D || ws_size < WS_END) { fprintf(stderr, "kernel_launch: unexpected shapes (n_in %d out %d ws %zu)\n", n_in, out_size, ws_size); grid = -1; return; }
        int dev = 0, cus = 0, per_cu = 0;
        hipGetDevice(&dev); hipDeviceGetAttribute(&cus, hipDeviceAttributeMultiprocessorCount, dev);
        if (hipFuncSetAttribute((const void*)mega_fwd, hipFuncAttributeMaxDynamicSharedMemorySize, LDS_BYTES) != hipSuccess) { fprintf(stderr, "kernel_launch: hipFuncSetAttribute failed\n"); grid = -1; return; }
        if (hipOccupancyMaxActiveBlocksPerMultiprocessor(&per_cu, (const void*)mega_fwd, 512, LDS_BYTES) != hipSuccess || per_cu < 1) { fprintf(stderr, "kernel_launch: occupancy query failed (%d)\n", per_cu); per_cu = 1; }
        (void)hipGetLastError();
        grid = cus * per_cu;
    }
    if (grid < 0) return;
    hipMemsetAsync((char*)d_ws + WS_CTL, 0, CTL_BYTES, stream);
    Params p{};
    p.x = (const float*)d_in[0]; p.norm_g = (const float*)d_in[1]; p.w_in = (const float*)d_in[2]; p.b_f = (const float*)d_in[3];
    p.pos_k = (const float*)d_in[4]; p.w1_k = (const float*)d_in[5]; p.w2_k = (const float*)d_in[6];
    p.pos_v = (const float*)d_in[7]; p.w1_v = (const float*)d_in[8]; p.w2_v = (const float*)d_in[9];
    p.w_out = (const float*)d_in[10]; p.final_g = (const float*)d_in[11]; p.out = (float*)d_out; p.ws = (unsigned char*)d_ws;
    void* args[] = {&p};
    const hipError_t e = hipLaunchCooperativeKernel((const void*)mega_fwd, dim3(grid), dim3(512), args, LDS_BYTES, stream);
    if (e != hipSuccess) fprintf(stderr, "cooperative launch failed: %s (grid %d)\n", hipGetErrorString(e), grid);
}
```

```cpp
#include <hip/hip_runtime.h>
#include <hip/hip_cooperative_groups.h>
#include <cstdio>
#include <cstdint>
namespace cg = cooperative_groups;
namespace pg8 {
#define PG8_LAS __attribute__((address_space(3)))
typedef unsigned short bf16_t;
typedef short bf16x8 __attribute__((ext_vector_type(8)));
typedef float f32x4 __attribute__((ext_vector_type(4)));
typedef unsigned u32x4 __attribute__((ext_vector_type(4)));
constexpr int BM = 256, BK = 64, HALF = 128, HTB = HALF * BK * 2  , STAGE_BYTES = 8 * HTB, NXCD = 8, WGM = 8;

__host__ __device__ __forceinline__ int lds_byte(int r, int c) { const int st = (r >> 4) * 2 + (c >> 5), rr = r & 15, cc = c & 31, ob = rr * 64 + cc * 2; return st * 1024 + (ob ^ (((ob >> 9) & 1) << 5)); }
__host__ __device__ __forceinline__ void stage_rc(int b, int& R, int& C) { const int st = b / 1024, sb = b % 1024, swz = sb ^ (((sb >> 9) & 1) << 5); R = (st >> 1) * 16 + swz / 64; C = (st & 1) * 32 + (swz % 64) / 2; }
__host__ __device__ __forceinline__ int perm32(int rho) { const int n = rho >> 4, i = rho & 15; return 8 * (i >> 2) + 4 * n + (i & 3); }

struct Unit { int pm, pn; };
struct Gemm { const bf16_t* A; const bf16_t* Bt; int M, N, K; };

struct StaticOrder {
    int nM, nN, nwg, G, c;
    __host__ __device__ void init(int M, int N, int G_, int c_) { nM = M / BM; nN = N / BM; nwg = nM * nN; G = G_; c = c_; }
    __host__ __device__ bool next(int i, Unit& u) const {
        const long L = (long)i * G + c; if (L >= nwg) return false;
        int wgid = (int)L; { const int q = nwg / NXCD, r = nwg % NXCD, xcd = wgid % NXCD, off = wgid / NXCD; wgid = (xcd < r ? xcd * (q + 1) : r * (q + 1) + (xcd - r) * q) + off; }
        const int nig = WGM * nN, gid = wgid / nig, fm = gid * WGM, gsz = (nM - fm) < WGM ? (nM - fm) : WGM;
        u.pm = fm + ((wgid % nig) % gsz); u.pn = (wgid % nig) / gsz; return true;
    }
    __device__ __forceinline__ void a_ready(const Unit&) const {}
    __device__ __forceinline__ void done(const Unit&) const {}
};

__device__ __forceinline__ unsigned cvt_pk_bf16(float lo, float hi) { unsigned r; asm volatile("v_cvt_pk_bf16_f32 %0, %1, %2" : "=v"(r) : "v"(lo), "v"(hi)); return r; }
template <class Epi, class Sched, bool ALIGN_EPI = false, bool SP2 = false>
__device__ __forceinline__ void gemm_phase(PG8_LAS unsigned char* lds, const Gemm g, const Sched& S, const Epi& E) {
    int tid_ = threadIdx.x; asm volatile("" : "+v"(tid_)); const int tid = tid_, wid = __builtin_amdgcn_readfirstlane(tid >> 6), lane = tid & 63, wr = wid >> 2, wc = wid & 3, fr = lane & 15, fq = lane >> 4;
    const int K = g.K, nt = K / BK;
    unsigned voffA[2], voffB[2];
#pragma unroll
    for (int i = 0; i < 2; ++i) { int R, C; stage_rc(tid * 16 + i * 8192, R, C); const int Rb = Epi::PERM ? ((R & ~31) + perm32(R & 31)) : R;
        voffA[i] = (unsigned)(R * K + C) * 2u; voffB[i] = (unsigned)(Rb * K + C) * 2u; }
    const size_t kstep = (size_t)(BK * 2);
    const size_t hstep = (size_t)HALF * K * 2;
    const size_t tstep = 2 * hstep;
    const unsigned ldsw = (unsigned)wid * 1024u;
    const int aoff = lds_byte(wr * 64 + fr, fq * 8), boff = lds_byte(wc * 32 + fr, fq * 8);
#define PG8_SA(b, h) (((b) * 2 + (h)) * HTB)
#define PG8_SB(b, h) ((4 + (b) * 2 + (h)) * HTB)
#define PG8_STAGE(bufoff, gbase, voff) do { _Pragma("unroll") for (int _i = 0; _i < 2; ++_i) \
        __builtin_amdgcn_global_load_lds((const unsigned*)((const char*)(gbase) + (voff)[_i]), (PG8_LAS unsigned*)(lds + (bufoff) + ldsw + _i * 8192), 16, 0, 0); } while (0)
#define PG8_LDA(dst, b, h) do { _Pragma("unroll") for (int m = 0; m < 4; ++m) _Pragma("unroll") for (int k = 0; k < 2; ++k) dst[m][k] = *(const PG8_LAS bf16x8*)(lds + PG8_SA(b, h) + aoff + m * 2048 + k * 1024); } while (0)
#define PG8_LDB(dst, b, h) do { _Pragma("unroll") for (int n = 0; n < 2; ++n) _Pragma("unroll") for (int k = 0; k < 2; ++k) dst[n][k] = *(const PG8_LAS bf16x8*)(lds + PG8_SB(b, h) + boff + n * 2048 + k * 1024); } while (0)
#define PG8_MMA(ai, bj, At, Bt) do { __builtin_amdgcn_s_setprio(1); _Pragma("unroll") for (int m = 0; m < 4; ++m) _Pragma("unroll") for (int n = 0; n < 2; ++n) _Pragma("unroll") for (int k = 0; k < 2; ++k) \
        acc[ai][bj][m][n] = __builtin_amdgcn_mfma_f32_16x16x32_bf16(Bt[n][k], At[m][k], acc[ai][bj][m][n], 0, 0, 0); __builtin_amdgcn_s_setprio(0); } while (0)
#define PG8_WAIT_V(n) asm volatile("s_waitcnt vmcnt(" #n ")" ::: "memory")
#define PG8_WAIT_L(n) asm volatile("s_waitcnt lgkmcnt(" #n ")" ::: "memory")
#define PG8_BAR __builtin_amdgcn_s_barrier()
#define PG8_SCHED __builtin_amdgcn_sched_barrier(0)
    Unit cur, nxt; int ui = 0;
    if (!S.next(0, cur)) return;
    f32x4 acc[2][2][4][2];
#pragma unroll
    for (int a = 0; a < 2; ++a)
#pragma unroll
        for (int b = 0; b < 2; ++b)
#pragma unroll
            for (int m = 0; m < 4; ++m)
#pragma unroll
                for (int n = 0; n < 2; ++n) acc[a][b][m][n] = (f32x4){0.f, 0.f, 0.f, 0.f};
    bf16x8 At[4][2], B0[2][2], B1[2][2];
    const char* cA = (const char*)g.A + (size_t)cur.pm * tstep; const char* cB = (const char*)g.Bt + (size_t)cur.pn * tstep;
    S.a_ready(cur);
    if constexpr (SP2) {
        PG8_STAGE(PG8_SB(0, 0), cB, voffB); PG8_STAGE(PG8_SB(0, 1), cB + hstep, voffB); PG8_STAGE(PG8_SA(0, 0), cA, voffA); PG8_STAGE(PG8_SA(0, 1), cA + hstep, voffA);
        if (wr == 1) PG8_BAR;
        PG8_WAIT_V(2); PG8_BAR;
        PG8_STAGE(PG8_SB(1, 0), cB + kstep, voffB); PG8_STAGE(PG8_SA(1, 0), cA + kstep, voffA); PG8_STAGE(PG8_SB(1, 1), cB + hstep + kstep, voffB);
        PG8_WAIT_V(6); PG8_BAR;
    } else {
        PG8_STAGE(PG8_SB(0, 0), cB, voffB); PG8_STAGE(PG8_SA(0, 0), cA, voffA); PG8_STAGE(PG8_SB(0, 1), cB + hstep, voffB); PG8_STAGE(PG8_SA(0, 1), cA + hstep, voffA);
        if (wr == 1) PG8_BAR;
        PG8_WAIT_V(4); PG8_BAR;
        PG8_STAGE(PG8_SB(1, 0), cB + kstep, voffB); PG8_STAGE(PG8_SA(1, 0), cA + kstep, voffA); PG8_STAGE(PG8_SB(1, 1), cB + hstep + kstep, voffB);
        PG8_WAIT_V(6); PG8_BAR;
    }
    for (;;) {
        const bool has_next = S.next(ui + 1, nxt);
        const char* nA = has_next ? (const char*)g.A + (size_t)nxt.pm * tstep : cA; const char* nB = has_next ? (const char*)g.Bt + (size_t)nxt.pn * tstep : cB;
        for (int t = 0; t < nt; t += 2) {
            const bool last = (t == nt - 2);
            const char* a1 = cA + (size_t)(t + 1) * kstep;
            const char* a2 = last ? nA : cA + (size_t)(t + 2) * kstep; const char* b2 = last ? nB : cB + (size_t)(t + 2) * kstep;
            const char* a3 = a2 + kstep; const char* b3 = b2 + kstep;
            if (last && has_next) S.a_ready(nxt);
            if constexpr (SP2) {
            PG8_LDB(B0, 0, 0); PG8_LDB(B1, 0, 1); PG8_SCHED; PG8_LDA(At, 0, 0); PG8_STAGE(PG8_SA(1, 1), a1 + hstep, voffA);
            PG8_WAIT_V(8); PG8_WAIT_L(0); PG8_BAR; PG8_MMA(0, 0, At, B0); PG8_MMA(0, 1, At, B1); PG8_BAR; PG8_SCHED;
            PG8_LDA(At, 0, 1); PG8_STAGE(PG8_SB(0, 0), b2, voffB); PG8_STAGE(PG8_SB(0, 1), b2 + hstep, voffB); PG8_STAGE(PG8_SA(0, 0), a2, voffA);
            PG8_WAIT_V(8); PG8_WAIT_L(0); PG8_BAR; PG8_MMA(1, 0, At, B0); PG8_MMA(1, 1, At, B1); PG8_BAR; PG8_SCHED;
            PG8_LDB(B0, 1, 0); PG8_LDB(B1, 1, 1); PG8_SCHED; PG8_LDA(At, 1, 0); PG8_STAGE(PG8_SA(0, 1), a2 + hstep, voffA);
            PG8_WAIT_V(8); PG8_WAIT_L(0); PG8_BAR; PG8_MMA(0, 0, At, B0); PG8_MMA(0, 1, At, B1); PG8_BAR; PG8_SCHED;
            PG8_LDA(At, 1, 1); PG8_STAGE(PG8_SB(1, 0), b3, voffB); PG8_STAGE(PG8_SB(1, 1), b3 + hstep, voffB); PG8_STAGE(PG8_SA(1, 0), a3, voffA);
            PG8_WAIT_V(8); PG8_WAIT_L(0); PG8_BAR; PG8_MMA(1, 0, At, B0); PG8_MMA(1, 1, At, B1); PG8_BAR; PG8_SCHED;
            } else {
            PG8_LDB(B0, 0, 0); PG8_SCHED; PG8_LDA(At, 0, 0); PG8_STAGE(PG8_SA(1, 1), a1 + hstep, voffA);
            PG8_WAIT_L(8); PG8_BAR; PG8_WAIT_L(0); PG8_MMA(0, 0, At, B0); PG8_BAR; PG8_SCHED;
            PG8_LDB(B1, 0, 1); PG8_STAGE(PG8_SB(0, 0), b2, voffB);
            PG8_BAR; PG8_WAIT_L(0); PG8_MMA(0, 1, At, B1); PG8_BAR;
            PG8_LDA(At, 0, 1); PG8_STAGE(PG8_SA(0, 0), a2, voffA);
            PG8_BAR; PG8_WAIT_L(0); PG8_MMA(1, 0, At, B0); PG8_BAR; PG8_SCHED;
            PG8_STAGE(PG8_SB(0, 1), b2 + hstep, voffB);
            PG8_WAIT_V(6); PG8_BAR; PG8_MMA(1, 1, At, B1); PG8_BAR;
            PG8_LDB(B0, 1, 0); PG8_SCHED; PG8_LDA(At, 1, 0); PG8_STAGE(PG8_SA(0, 1), a2 + hstep, voffA);
            PG8_WAIT_L(8); PG8_BAR; PG8_WAIT_L(0); PG8_MMA(0, 0, At, B0); PG8_BAR; PG8_SCHED;
            PG8_LDB(B1, 1, 1); PG8_STAGE(PG8_SB(1, 0), b3, voffB);
            PG8_BAR; PG8_WAIT_L(0); PG8_MMA(0, 1, At, B1); PG8_BAR;
            PG8_LDA(At, 1, 1); PG8_STAGE(PG8_SA(1, 0), a3, voffA);
            PG8_BAR; PG8_WAIT_L(0); PG8_MMA(1, 0, At, B0); PG8_BAR; PG8_SCHED;
            PG8_STAGE(PG8_SB(1, 1), b3 + hstep, voffB);
            PG8_WAIT_V(6); PG8_BAR; PG8_MMA(1, 1, At, B1); PG8_BAR;
            }
        }
        if constexpr (ALIGN_EPI) { if (wr == 0) PG8_BAR; }
        if constexpr (!Epi::AFTER_DRAIN) { E(acc, cur, wr, wc, fr, fq); S.done(cur); }
        if (!has_next) break;
#pragma unroll
        for (int a = 0; a < 2; ++a)
#pragma unroll
            for (int b = 0; b < 2; ++b)
#pragma unroll
                for (int m = 0; m < 4; ++m)
#pragma unroll
                    for (int n = 0; n < 2; ++n) acc[a][b][m][n] = (f32x4){0.f, 0.f, 0.f, 0.f};
        cur = nxt; cA = nA; cB = nB; ++ui;
        if constexpr (ALIGN_EPI) { if (wr == 1) PG8_BAR; }
    }
    PG8_WAIT_V(0);
    if constexpr (!ALIGN_EPI) { if (wr == 0) PG8_BAR; }
    PG8_BAR;
    if constexpr (Epi::AFTER_DRAIN) { E.fused(acc, cur, wr, wc, fr, fq, lds, wid, lane); S.done(cur); }
#undef PG8_SA
#undef PG8_SB
#undef PG8_STAGE
#undef PG8_LDA
#undef PG8_LDB
#undef PG8_MMA
#undef PG8_WAIT_V
#undef PG8_WAIT_L
#undef PG8_BAR
#undef PG8_SCHED
}
}

#define LAS __attribute__((address_space(3)))
#define DI __device__ __forceinline__
typedef unsigned short bf16;
typedef short bf16x8 __attribute__((ext_vector_type(8)));
typedef short s16x4 __attribute__((ext_vector_type(4)));
typedef float f32x4 __attribute__((ext_vector_type(4)));
typedef float f32x16 __attribute__((ext_vector_type(16)));
typedef unsigned u32x4 __attribute__((ext_vector_type(4)));
typedef unsigned u32x2 __attribute__((ext_vector_type(2)));
typedef LAS const char* lds_cptr;
typedef short v4i16_t __attribute__((ext_vector_type(4)));
typedef float f32x2_t __attribute__((ext_vector_type(2)));
typedef __bf16 bf16x2_t __attribute__((ext_vector_type(2)));

constexpr int S = 2048, NB = 32, M = NB * S, D = 1024, NP = 4096, DIN = 3986;
constexpr int C_FQ = 0, C_FK = 384, C_FV = 768, C_FZ = 1152, C_SQ = 1536, C_SK = 1920, C_SV = 2304, C_SZ = 2688, C_NQ = 3072, C_NKC = 3328, C_NVC = 3392,
              C_NKS = 3456, C_NVS = 3520, C_NKW = 3584, C_NVW = 3648, C_NZ = 3712;
constexpr size_t MiB = 1u << 20;
constexpr size_t WS_CTL = 0, CTL_BYTES = 32768;
constexpr size_t WS_WTIN = 2 * MiB;
constexpr size_t WS_WTOUT = 18 * MiB;
constexpr size_t WS_W1T = 22 * MiB;
constexpr size_t WS_W2T = 23 * MiB;
constexpr size_t WS_PB = 23 * MiB + 65536;
constexpr size_t WS_KC = 24 * MiB;
constexpr size_t WS_VC = 25 * MiB;
constexpr size_t WS_AUX = 26 * MiB;
constexpr size_t WS_H = 64 * MiB;
constexpr size_t WS_PROJ = 192 * MiB;
constexpr size_t WS_END = 704 * MiB;
constexpr int STG = 18432;
constexpr int L_CBUF = 36864;
constexpr int L_IMP = 45056;
constexpr int L_SELM = 78848;
constexpr int L_MISC = 79104;
constexpr int L_RED = 36864;
constexpr int L_HID = 69632;
constexpr int L_TACC = 81920;
constexpr int L_XB = 147456;
constexpr int LDS_BYTES = 147712;
constexpr float C2 = 0.125f * 1.4426950408889634f;
#ifndef REP_P1
#define REP_P1 1
#endif
#ifndef REP_P2
#define REP_P2 1
#endif
#ifndef REP_P3
#define REP_P3 1
#endif
constexpr float NEGX = -1e30f, MINIT = -1e28f;

DI unsigned f2bf(float f) { unsigned u = __float_as_uint(f); return (u + 0x7fffu + ((u >> 16) & 1u)) >> 16; }
DI float bf2f(unsigned h) { return __uint_as_float(h << 16); }
DI unsigned cvtpk(float lo, float hi) { f32x2_t v = {lo, hi}; bf16x2_t b = __builtin_convertvector(v, bf16x2_t); return __builtin_bit_cast(unsigned, b); }
DI float ex2(float x) { return __builtin_amdgcn_exp2f(x); }
DI float wave_sum(float v) {
#pragma unroll
    for (int o = 1; o < 64; o <<= 1) v += __shfl_xor(v, o);
    return v;
}
DI float sigm_f(float z) { return __builtin_amdgcn_rcpf(1.f + ex2(-1.4426950408889634f * z)); }
DI float silu_f(float z) { return z * sigm_f(z); }
DI int crow(int i, int hi) { return (i & 3) + 8 * (i >> 2) + 4 * hi; }
DI s16x4 vtr(lds_cptr p) { return __builtin_bit_cast(s16x4, __builtin_amdgcn_ds_read_tr16_b64_v4i16((LAS v4i16_t*)p)); }
#define MFMA32(a, b, c) __builtin_amdgcn_mfma_f32_32x32x16_bf16((a), (b), (c), 0, 0, 0)
#define MFMA16(a, b, c) __builtin_amdgcn_mfma_f32_16x16x32_bf16((a), (b), (c), 0, 0, 0)

DI void kv_issue(const bf16* Kt, const bf16* Vt, int pitch, int wid, int lane, u32x4& kr, u32x4& vr) {
    kr = *(const u32x4*)(Kt + (size_t)lane * pitch + 8 * wid);
    vr = *(const u32x4*)(Vt + (size_t)(16 * (wid & 3) + (lane >> 2)) * pitch + (wid >> 2) * 32 + (lane & 3) * 8);
}
DI void kv_commit(char* buf, int tid, int wid, int lane, const u32x4& kr, const u32x4& vr, const u32x4& ar) {
    *(u32x4*)(buf + tid * 16) = kr;
    *(u32x4*)(buf + 9216 + tid * 16) = vr;
    if (wid == 0) *(u32x4*)(buf + 8192 + lane * 16) = ar;
}
DI void qk_tile(const char* kb, const bf16x8 (&qr)[5], int r32, int hi, f32x16& x0, f32x16& x1) {
    bf16x8 kf[10];
#pragma unroll
    for (int d0 = 0; d0 < 4; ++d0) {
        kf[2 * d0] = *(const bf16x8*)(kb + (2 * d0 + hi) * 1024 + r32 * 16);
        kf[2 * d0 + 1] = *(const bf16x8*)(kb + (2 * d0 + hi) * 1024 + 512 + r32 * 16);
    }
    kf[8] = *(const bf16x8*)(kb + 8192 + r32 * 16);
    kf[9] = *(const bf16x8*)(kb + 8192 + 512 + r32 * 16);
    asm volatile("s_waitcnt lgkmcnt(0)" ::: "memory");
#pragma unroll
    for (int i = 0; i < 16; ++i) { x0[i] = 0.f; x1[i] = 0.f; }
#pragma unroll
    for (int d0 = 0; d0 < 5; ++d0) { x0 = MFMA32(kf[2 * d0], qr[d0], x0); x1 = MFMA32(kf[2 * d0 + 1], qr[d0], x1); }
}
DI void v_load(const char* vb, int lane, int hi, bf16x8 (&vf)[8]) {
    const lds_cptr vp = (lds_cptr)vb + ((lane >> 4) & 1) * 32 + (lane & 3) * 8 + (4 * hi + ((lane & 15) >> 2)) * 64;
#pragma unroll
    for (int ks = 0; ks < 4; ++ks) {
        { const s16x4 lo = vtr(vp + ks * 1024), hh = vtr(vp + ks * 1024 + 512); vf[ks] = (bf16x8){lo[0], lo[1], lo[2], lo[3], hh[0], hh[1], hh[2], hh[3]}; }
        { const s16x4 lo = vtr(vp + 4096 + ks * 1024), hh = vtr(vp + 4096 + ks * 1024 + 512); vf[4 + ks] = (bf16x8){lo[0], lo[1], lo[2], lo[3], hh[0], hh[1], hh[2], hh[3]}; }
    }
    asm volatile("" ::: "memory");
}
DI void pv_tile(const bf16x8 (&vf)[8], const f32x16& p0, const f32x16& p1, f32x16& o0, f32x16& o1) {
    u32x4 w[4];
#pragma unroll
    for (int j = 0; j < 4; ++j) { w[0][j] = cvtpk(p0[2 * j], p0[2 * j + 1]); w[1][j] = cvtpk(p0[8 + 2 * j], p0[9 + 2 * j]);
                                  w[2][j] = cvtpk(p1[2 * j], p1[2 * j + 1]); w[3][j] = cvtpk(p1[8 + 2 * j], p1[9 + 2 * j]); }
#pragma unroll
    for (int ks = 0; ks < 4; ++ks) { const bf16x8 pb = __builtin_bit_cast(bf16x8, w[ks]); o0 = MFMA32(vf[ks], pb, o0); o1 = MFMA32(vf[4 + ks], pb, o1); }
}
DI void mask_tile(f32x16& x0, f32x16& x1, int klo, int khi, int hi) {
#pragma unroll
    for (int i = 0; i < 16; ++i) { const int k = crow(i, hi); if (k < klo || k > khi) x0[i] = NEGX; if (k + 32 < klo || k + 32 > khi) x1[i] = NEGX; }
}
DI float tile_max(const f32x16& x0, const f32x16& x1) {
    float ma = __builtin_fmaxf(x0[0], x1[0]), mb = __builtin_fmaxf(x0[1], x1[1]);
#pragma unroll
    for (int i = 2; i < 16; i += 2) { ma = __builtin_fmaxf(__builtin_fmaxf(ma, x0[i]), x1[i]); mb = __builtin_fmaxf(__builtin_fmaxf(mb, x0[i + 1]), x1[i + 1]); }
    const float mx = __builtin_fmaxf(ma, mb);
    return __builtin_fmaxf(mx, __shfl_xor(mx, 32));
}
DI void smx_tile(f32x16& x0, f32x16& x1, float& m, float& l, f32x16& o0, f32x16& o1) {
    const float mn = fmaxf(m, tile_max(x0, x1) * C2);
    const float al = ex2(m - mn); m = mn; l *= al;
    if (__any(al != 1.f)) {
#pragma unroll
        for (int i = 0; i < 16; ++i) { o0[i] *= al; o1[i] *= al; }
    }
    float s = 0.f;
#pragma unroll
    for (int i = 0; i < 16; ++i) { x0[i] = ex2(fmaf(x0[i], C2, -mn)); x1[i] = ex2(fmaf(x1[i], C2, -mn)); s += x0[i] + x1[i]; }
    l += s;
}
DI void smx_tile_sel(f32x16& x0, f32x16& x1, float& m, float& l, f32x16& o0, f32x16& o1, bool sel) {
    const float tm = tile_max(x0, x1) * C2;
    const float mn = sel ? fmaxf(m, tm) : m;
    const float al = ex2(m - mn); m = mn; l *= al;
    if (__any(al != 1.f)) {
#pragma unroll
        for (int i = 0; i < 16; ++i) { o0[i] *= al; o1[i] *= al; }
    }
    const float sub = sel ? mn : 3.0e38f;
    float s = 0.f;
#pragma unroll
    for (int i = 0; i < 16; ++i) { x0[i] = ex2(fmaf(x0[i], C2, -sub)); x1[i] = ex2(fmaf(x1[i], C2, -sub)); s += x0[i] + x1[i]; }
    l += s;
}
DI void smx_stats(const f32x16& x0, const f32x16& x1, float& m, float& l) {
    const float mn = fmaxf(m, tile_max(x0, x1) * C2);
    l *= ex2(m - mn); m = mn;
    float s = 0.f;
#pragma unroll
    for (int i = 0; i < 16; ++i) s += ex2(fmaf(x0[i], C2, -mn)) + ex2(fmaf(x1[i], C2, -mn));
    l += s;
}
DI void sb_tile(f32x16& x0, f32x16& x1, float& R, int hi) {
#pragma unroll
    for (int i = 0; i < 16; ++i) { x0[i] = __builtin_amdgcn_rcpf(1.f + ex2(x0[i] * C2)); x1[i] = __builtin_amdgcn_rcpf(1.f + ex2(x1[i] * C2)); }
    float qp[8], pq[8];
#pragma unroll
    for (int g = 0; g < 4; ++g) { qp[g] = (x0[4 * g] * x0[4 * g + 1]) * (x0[4 * g + 2] * x0[4 * g + 3]); qp[4 + g] = (x1[4 * g] * x1[4 * g + 1]) * (x1[4 * g + 2] * x1[4 * g + 3]); }
#pragma unroll
    for (int g = 0; g < 8; ++g) pq[g] = __shfl_xor(qp[g], 32);
    float Sfx = R;
#pragma unroll
    for (int gg = 7; gg >= 0; --gg) {
        float base = Sfx * (hi ? 1.f : pq[gg]);
        f32x16& x = (gg >= 4) ? x1 : x0; const int q4 = 4 * (gg & 3);
        const float r3 = x[q4 + 3], r2 = x[q4 + 2], r1 = x[q4 + 1], r0 = x[q4];
        x[q4 + 3] = fmaf(-r3, base, base); base *= r3;
        x[q4 + 2] = fmaf(-r2, base, base); base *= r2;
        x[q4 + 1] = fmaf(-r1, base, base); base *= r1;
        x[q4] = fmaf(-r0, base, base);
        Sfx *= qp[gg] * pq[gg];
    }
    R = Sfx;
}
DI void write_out(const f32x16& o0, const f32x16& o1, float sc, const bf16* zrow, bf16* orow, int hi) {
#pragma unroll
    for (int d0 = 0; d0 < 2; ++d0)
#pragma unroll
        for (int gq = 0; gq < 4; ++gq) {
            const int d = 32 * d0 + 8 * gq + 4 * hi;
            const u32x2 zz = *(const u32x2*)(zrow + d);
            const f32x16& o = d0 ? o1 : o0;
            const float v0 = o[4 * gq] * sc * silu_f(bf2f(zz.x & 0xffffu)), v1 = o[4 * gq + 1] * sc * silu_f(bf2f(zz.x >> 16));
            const float v2 = o[4 * gq + 2] * sc * silu_f(bf2f(zz.y & 0xffffu)), v3 = o[4 * gq + 3] * sc * silu_f(bf2f(zz.y >> 16));
            u32x2 w; w.x = cvtpk(v0, v1); w.y = cvtpk(v2, v3);
            *(u32x2*)(orow + d) = w;
        }
}
DI void write_out_t(const f32x16& o0, const f32x16& o1, float sc, const bf16* zrow0, size_t zpitch, bf16* orow0, size_t opitch, float* st, int lane) {
    const int q = lane & 31, hi = lane >> 5;
#pragma unroll
    for (int d0 = 0; d0 < 2; ++d0)
#pragma unroll
        for (int gq = 0; gq < 4; ++gq) {
            const int ch = 8 * d0 + 2 * gq + hi; const f32x16& o = d0 ? o1 : o0;
            *(f32x4*)(st + q * 64 + ((ch ^ (q & 15)) << 2)) = (f32x4){o[4 * gq] * sc, o[4 * gq + 1] * sc, o[4 * gq + 2] * sc, o[4 * gq + 3] * sc};
        }
#pragma unroll
    for (int j = 0; j < 4; ++j) {
        const int row = (lane >> 3) + 8 * j, c = lane & 7;
        const f32x4 a = *(const f32x4*)(st + row * 64 + (((2 * c) ^ (row & 15)) << 2)), b = *(const f32x4*)(st + row * 64 + (((2 * c + 1) ^ (row & 15)) << 2));
        const u32x4 zz = *(const u32x4*)(zrow0 + (size_t)row * zpitch + 8 * c);
        u32x4 w;
        w.x = cvtpk(a[0] * silu_f(bf2f(zz.x & 0xffffu)), a[1] * silu_f(bf2f(zz.x >> 16)));
        w.y = cvtpk(a[2] * silu_f(bf2f(zz.y & 0xffffu)), a[3] * silu_f(bf2f(zz.y >> 16)));
        w.z = cvtpk(b[0] * silu_f(bf2f(zz.z & 0xffffu)), b[1] * silu_f(bf2f(zz.z >> 16)));
        w.w = cvtpk(b[2] * silu_f(bf2f(zz.w & 0xffffu)), b[3] * silu_f(bf2f(zz.w >> 16)));
        *(u32x4*)(orow0 + (size_t)row * opitch + 8 * c) = w;
    }
}
DI void write_out_z(const f32x16& o0, const f32x16& o1, float sc, const u32x4 (&zpre)[4], bf16* orow0, size_t opitch, float* st, int lane) {
    const int q = lane & 31, hi = lane >> 5;
#pragma unroll
    for (int d0 = 0; d0 < 2; ++d0)
#pragma unroll
        for (int gq = 0; gq < 4; ++gq) {
            const int ch = 8 * d0 + 2 * gq + hi; const f32x16& o = d0 ? o1 : o0;
            *(f32x4*)(st + q * 64 + ((ch ^ (q & 15)) << 2)) = (f32x4){o[4 * gq] * sc, o[4 * gq + 1] * sc, o[4 * gq + 2] * sc, o[4 * gq + 3] * sc};
        }
#pragma unroll
    for (int j = 0; j < 4; ++j) {
        const int row = (lane >> 3) + 8 * j, c = lane & 7;
        const f32x4 a = *(const f32x4*)(st + row * 64 + (((2 * c) ^ (row & 15)) << 2)), b = *(const f32x4*)(st + row * 64 + (((2 * c + 1) ^ (row & 15)) << 2));
        const u32x4 zz = zpre[j];
        u32x4 w;
        w.x = cvtpk(a[0] * silu_f(bf2f(zz.x & 0xffffu)), a[1] * silu_f(bf2f(zz.x >> 16)));
        w.y = cvtpk(a[2] * silu_f(bf2f(zz.y & 0xffffu)), a[3] * silu_f(bf2f(zz.y >> 16)));
        w.z = cvtpk(b[0] * silu_f(bf2f(zz.z & 0xffffu)), b[1] * silu_f(bf2f(zz.z >> 16)));
        w.w = cvtpk(b[2] * silu_f(bf2f(zz.w & 0xffffu)), b[3] * silu_f(bf2f(zz.w >> 16)));
        *(u32x4*)(orow0 + (size_t)row * opitch + 8 * c) = w;
    }
}
DI void write_out_zh(const f32x16& o0, const f32x16& o1, float sc, const u32x4 (&zpre)[2], const bf16* zrow0, size_t zpitch, bf16* orow0, size_t opitch, float* st, int lane) {
    const int q = lane & 31, hi = lane >> 5;
#pragma unroll
    for (int d0 = 0; d0 < 2; ++d0)
#pragma unroll
        for (int gq = 0; gq < 4; ++gq) {
            const int ch = 8 * d0 + 2 * gq + hi; const f32x16& o = d0 ? o1 : o0;
            *(f32x4*)(st + q * 64 + ((ch ^ (q & 15)) << 2)) = (f32x4){o[4 * gq] * sc, o[4 * gq + 1] * sc, o[4 * gq + 2] * sc, o[4 * gq + 3] * sc};
        }
#pragma unroll
    for (int j = 0; j < 4; ++j) {
        const int row = (lane >> 3) + 8 * j, c = lane & 7;
        const f32x4 a = *(const f32x4*)(st + row * 64 + (((2 * c) ^ (row & 15)) << 2)), b = *(const f32x4*)(st + row * 64 + (((2 * c + 1) ^ (row & 15)) << 2));
        const u32x4 zz = j < 2 ? zpre[j & 1] : *(const u32x4*)(zrow0 + (size_t)row * zpitch + 8 * c);
        u32x4 w;
        w.x = cvtpk(a[0] * silu_f(bf2f(zz.x & 0xffffu)), a[1] * silu_f(bf2f(zz.x >> 16)));
        w.y = cvtpk(a[2] * silu_f(bf2f(zz.y & 0xffffu)), a[3] * silu_f(bf2f(zz.y >> 16)));
        w.z = cvtpk(b[0] * silu_f(bf2f(zz.z & 0xffffu)), b[1] * silu_f(bf2f(zz.z >> 16)));
        w.w = cvtpk(b[2] * silu_f(bf2f(zz.w & 0xffffu)), b[3] * silu_f(bf2f(zz.w >> 16)));
        *(u32x4*)(orow0 + (size_t)row * opitch + 8 * c) = w;
    }
}
DI u32x4 split3(float a) {
    const unsigned h = f2bf(a); const float r1 = a - bf2f(h); const unsigned m = f2bf(r1); const unsigned l = f2bf(r1 - bf2f(m));
    u32x4 r; r.x = h | (m << 16); r.y = l; r.z = 0u; r.w = 0u; return r;
}
DI u32x4 pos_aug(int pos) {
    u32x4 r; r.x = f2bf((float)(pos & ~7)) | (f2bf((float)(pos & 7)) << 16); r.y = 0u; r.z = 0u; r.w = 0u; return r;
}


DI void fox_unit(const bf16* PR, const float* AUX, const float* bfp, bf16* MIX, char* sm, int b, int h, int qb, bool do_cs) {
    int tid_ = threadIdx.x; asm volatile("" : "+v"(tid_)); const int tid = tid_, lane = tid & 63, r32 = lane & 31, hi = lane >> 5, wid = __builtin_amdgcn_readfirstlane(tid >> 6);
    float* cbuf = (float*)(sm + L_CBUF); float* miscf = (float*)(sm + L_MISC);
    const int nkeys = 256 * (qb + 1), q0 = 256 * qb; const size_t rb = (size_t)b * S;
    if (do_cs) {
        float v[4]; float run = 0.f; const float bias = bfp[h];
#pragma unroll
        for (int e = 0; e < 4; ++e) { const int s = 4 * tid + e; float ls = 0.f;
            if (s < nkeys) { const float x = AUX[(rb + s) * 32 + h] + bias; ls = fminf(x, 0.f) - 0.6931471805599453f * __builtin_amdgcn_logf(1.f + ex2(-1.4426950408889634f * fabsf(x))); }
            run += ls; v[e] = run; }
        float tot = run;
#pragma unroll
        for (int o = 1; o < 64; o <<= 1) { const float y = __shfl_up(tot, o); if (lane >= o) tot += y; }
        if (lane == 63) miscf[24 + wid] = tot;
        __syncthreads();
        float off = tot - run;
        for (int w = 0; w < wid; ++w) off += miscf[24 + w];
#pragma unroll
        for (int e = 0; e < 4; ++e) cbuf[4 * tid + e] = v[e] + off;
        __syncthreads();
    }
    const int t = q0 + 32 * wid + r32;
    bf16x8 qr[5];
#pragma unroll
    for (int d0 = 0; d0 < 4; ++d0) qr[d0] = *(const bf16x8*)(PR + (rb + t) * NP + C_FQ + 64 * h + 16 * d0 + 8 * hi);
    { const short one = hi ? (short)0 : (short)0x3F80; qr[4] = (bf16x8){one, one, one, 0, 0, 0, 0, 0}; }
    const float cref = cbuf[q0];
    const bf16* Kb = PR + rb * NP + C_FK + 64 * h; const bf16* Vb = PR + rb * NP + C_FV + 64 * h;
    float m = MINIT, l = 0.f; f32x16 o0, o1;
#pragma unroll
    for (int i = 0; i < 16; ++i) { o0[i] = 0.f; o1[i] = 0.f; }
    unsigned z_ = 0u; asm volatile("" : "+v"(z_)); u32x4 kr, vr, ar = {z_, z_, z_, z_};
    const int wq0 = q0 + 32 * wid;
    u32x4 zpre[4];
    const bf16* zrow0 = PR + (rb + wq0) * NP + C_FZ + 64 * h;
    float q1 = 0.f;
#pragma unroll
    for (int d0 = 0; d0 < 4; ++d0)
#pragma unroll
        for (int j = 0; j < 8; ++j) q1 += fabsf(bf2f((unsigned)(unsigned short)qr[d0][j]));
    q1 += __shfl_xor(q1, 32);
    volatile LAS unsigned* kmx = (volatile LAS unsigned*)(sm + L_MISC) + 32;
    for (int it_ = -1, nt_ = (4 * qb + 4); it_ < nt_; ++it_) {
        const bool more_ = it_ + 1 < nt_;
        if (!more_) {
#pragma unroll
            for (int j = 0; j < 4; ++j) zpre[j] = *(const u32x4*)(zrow0 + (size_t)((lane >> 3) + 8 * j) * NP + 8 * (lane & 7));
        }
        if (more_) { const int kt = nt_ - 2 - it_; { kv_issue(Kb + (size_t)(64 * kt) * NP, Vb + (size_t)(64 * kt) * NP, NP, wid, lane, kr, vr);
          if (wid == 0) ar = split3(8.f * (cref - cbuf[64 * kt + lane])); } }
        if (it_ >= 0) { const int kt = nt_ - 1 - it_; const char* cb = sm + (it_ & 1) * STG; { if (64 * kt <= wq0 + 31) {
              unsigned kb_ = 0u;
#pragma unroll
              for (int w = 0; w < 8; ++w) { const unsigned v_ = kmx[(it_ & 1) * 8 + w]; kb_ = v_ > kb_ ? v_ : kb_; }
              const float ub = C2 * (q1 * bf2f(kb_) + 8.f * (cref - cbuf[64 * kt + 63]));
              if (!__all(ub - m < -151.f)) {
                  f32x16 x0, x1; qk_tile(cb, qr, r32, hi, x0, x1); bf16x8 vf[8]; v_load(cb + 9216, lane, hi, vf);
                  if (64 * kt + 63 > wq0) mask_tile(x0, x1, 0, t - 64 * kt, hi);
                  smx_tile(x0, x1, m, l, o0, o1);
                  pv_tile(vf, x0, x1, o0, o1); } } } }
        if (more_) { kv_commit(sm + ((it_ + 1) & 1) * STG, tid, wid, lane, kr, vr, ar);
            const bool far_ = 64 * (nt_ - 2 - it_) + 63 + 384 < q0;
            unsigned mk = 0x7f80u;
            if (far_) { mk = (kr.x & 0x7fffu); { const unsigned t1 = (kr.x >> 16) & 0x7fffu; mk = t1 > mk ? t1 : mk; }
            { const unsigned t0 = kr.y & 0x7fffu, t1 = (kr.y >> 16) & 0x7fffu; mk = t0 > mk ? t0 : mk; mk = t1 > mk ? t1 : mk; }
            { const unsigned t0 = kr.z & 0x7fffu, t1 = (kr.z >> 16) & 0x7fffu; mk = t0 > mk ? t0 : mk; mk = t1 > mk ? t1 : mk; }
            { const unsigned t0 = kr.w & 0x7fffu, t1 = (kr.w >> 16) & 0x7fffu; mk = t0 > mk ? t0 : mk; mk = t1 > mk ? t1 : mk; }
#pragma unroll
            for (int o = 1; o < 64; o <<= 1) { const unsigned y = (unsigned)__shfl_xor((int)mk, o); mk = y > mk ? y : mk; } }
            if (lane == 0) kmx[((it_ + 1) & 1) * 8 + wid] = mk; }
        __syncthreads();
    }

    const float lt = l + __shfl_xor(l, 32);
    write_out_z(o0, o1, lt > 0.f ? 1.f / lt : 0.f, zpre, MIX + (rb + wq0) * D + 64 * h, D, (float*)(sm + L_TACC) + wid * 2048, lane);
}

DI void sb_unit(const bf16* PR, bf16* MIX, char* sm, int b, int h, int qb) {
    int tid_ = threadIdx.x; asm volatile("" : "+v"(tid_)); const int tid = tid_, lane = tid & 63, r32 = lane & 31, hi = lane >> 5, wid = __builtin_amdgcn_readfirstlane(tid >> 6);
    volatile LAS unsigned* misc = (volatile LAS unsigned*)(sm + L_MISC);
    const int q0 = 256 * qb; const size_t rb = (size_t)b * S;
    const int t = q0 + 32 * wid + r32, wq0 = q0 + 32 * wid;
    bf16x8 qr[5];
#pragma unroll
    for (int d0 = 0; d0 < 4; ++d0) qr[d0] = *(const bf16x8*)(PR + (rb + t) * NP + C_SQ + 64 * h + 16 * d0 + 8 * hi);
    qr[4] = (bf16x8){0, 0, 0, 0, 0, 0, 0, 0};
    const bf16* Kb = PR + rb * NP + C_SK + 64 * h; const bf16* Vb = PR + rb * NP + C_SV + 64 * h;
    float R = 1.f; f32x16 o0, o1;
#pragma unroll
    for (int i = 0; i < 16; ++i) { o0[i] = 0.f; o1[i] = 0.f; }
    unsigned z_ = 0u; asm volatile("" : "+v"(z_)); u32x4 kr, vr, ar = {z_, z_, z_, z_};
    const int nt = 4 * qb + 4;
    u32x4 zpre[4];
    { const bf16* zrow0 = PR + (rb + wq0) * NP + C_SZ + 64 * h;
#pragma unroll
      for (int j = 0; j < 4; ++j) zpre[j] = *(const u32x4*)(zrow0 + (size_t)((lane >> 3) + 8 * j) * NP + 8 * (lane & 7)); }
    { const int kt = nt - 1; kv_issue(Kb + (size_t)(64 * kt) * NP, Vb + (size_t)(64 * kt) * NP, NP, wid, lane, kr, vr); }
    kv_commit(sm, tid, wid, lane, kr, vr, ar); __syncthreads();
    for (int it = 0; it < nt; ++it) {
        const int kt = nt - 1 - it; const char* cb = sm + (it & 1) * STG; const bool more = it + 1 < nt;
        if (more) kv_issue(Kb + (size_t)(64 * (kt - 1)) * NP, Vb + (size_t)(64 * (kt - 1)) * NP, NP, wid, lane, kr, vr);
        bool wdone = false;
        if (64 * kt <= wq0 + 30) {
            if (__any(R >= 1e-30f)) {
                f32x16 x0, x1; qk_tile(cb, qr, r32, hi, x0, x1); bf16x8 vf[8]; v_load(cb + 9216, lane, hi, vf);
                if (64 * kt + 63 >= wq0) mask_tile(x0, x1, 0, t - 1 - 64 * kt, hi);
                sb_tile(x0, x1, R, hi);
                pv_tile(vf, x0, x1, o0, o1);
            }
            wdone = !__any(R >= 1e-30f);
        }
        if (lane == 0) misc[2 + (it & 1) * 8 + wid] = wdone ? 1u : 0u;
        if (more) kv_commit(sm + ((it + 1) & 1) * STG, tid, wid, lane, kr, vr, ar);
        __syncthreads();
        unsigned alld = 1u;
#pragma unroll
        for (int w = 0; w < 8; ++w) alld &= misc[2 + (it & 1) * 8 + w];
        if (alld) break;
    }
    __syncthreads();
    write_out_z(o0, o1, 1.f, zpre, MIX + (rb + wq0) * D + 384 + 64 * h, D, (float*)(sm + L_TACC) + wid * 2048, lane);
}

DI void cmp_unit(const bf16* PR, const bf16* W1T, const bf16* W2T, const float* PB, bf16* OUT, int col, char* sm, int b, int ntile) {
    int tid_ = threadIdx.x; asm volatile("" : "+v"(tid_)); const int tid = tid_, lane = tid & 63, wid = __builtin_amdgcn_readfirstlane(tid >> 6);
    float* red = (float*)(sm + L_RED); float* hid = (float*)(sm + L_HID);
    const int row = lane & 15, kq = lane >> 4;
    const int n = 16 * ntile + row, nc = n < 126 ? n : 126;
    f32x4 acc[4];
#pragma unroll
    for (int e = 0; e < 4; ++e) acc[e] = (f32x4){0.f, 0.f, 0.f, 0.f};
#pragma unroll
    for (int half = 0; half < 2; ++half) {
        bf16x8 af[4], bfr[4][4];
#pragma unroll
        for (int s4 = 0; s4 < 4; ++s4) {
            const int f0 = 256 * wid + 32 * (4 * half + s4) + 8 * kq, tl = f0 >> 6, d = f0 & 63;
            af[s4] = *(const bf16x8*)(PR + ((size_t)b * S + 16 * nc + tl) * NP + col + d);
#pragma unroll
            for (int et = 0; et < 4; ++et) bfr[s4][et] = *(const bf16x8*)(W1T + (size_t)(16 * et + row) * 2048 + f0);
        }
#pragma unroll
        for (int s4 = 0; s4 < 4; ++s4)
#pragma unroll
            for (int et = 0; et < 4; ++et) acc[et] = MFMA16(af[s4], bfr[s4][et], acc[et]);
    }
#pragma unroll
    for (int et = 0; et < 4; ++et)
#pragma unroll
        for (int j = 0; j < 4; ++j) red[(wid * 16 + kq * 4 + j) * 64 + 16 * et + row] = acc[et][j];
    __syncthreads();
    for (int idx = tid; idx < 1024; idx += 512) { float s = 0.f;
#pragma unroll
        for (int w = 0; w < 8; ++w) s += red[w * 1024 + idx];
        s += PB[idx & 63]; hid[idx] = silu_f(s); }
    __syncthreads();
    if (wid < 4) {
        f32x4 c = (f32x4){0.f, 0.f, 0.f, 0.f};
#pragma unroll
        for (int step = 0; step < 2; ++step) {
            const float* hp = hid + row * 64 + 32 * step + 8 * kq;
            u32x4 aw; aw.x = cvtpk(hp[0], hp[1]); aw.y = cvtpk(hp[2], hp[3]); aw.z = cvtpk(hp[4], hp[5]); aw.w = cvtpk(hp[6], hp[7]);
            const bf16x8 bb = *(const bf16x8*)(W2T + (size_t)(16 * wid + row) * 64 + 32 * step + 8 * kq);
            c = MFMA16(__builtin_bit_cast(bf16x8, aw), bb, c);
        }
#pragma unroll
        for (int j = 0; j < 4; ++j) { const int nn = 16 * ntile + kq * 4 + j; OUT[((size_t)b * 128 + nn) * 64 + 16 * wid + row] = (bf16)(nn <= 126 ? f2bf(c[j]) : 0u); }
    }
    __syncthreads();
}

DI int nth_set_desc(unsigned m, int n) { for (int i = 0; i < n; ++i) m &= ~(1u << (31 - __clz((int)m))); return 31 - __clz((int)m); }
DI int nth_set(unsigned m, int n) { for (int i = 0; i < n; ++i) m &= m - 1u; return __ffs((int)m) - 1; }
DI void nsa_unit(const bf16* PR, const float* AUX, const bf16* KC, const bf16* VC, bf16* MIX, char* sm, int b, int qb) {
    int tid_ = threadIdx.x; asm volatile("" : "+v"(tid_)); const int tid = tid_, lane = tid & 63, r32 = lane & 31, hi = lane >> 5, wid = __builtin_amdgcn_readfirstlane(tid >> 6);
    float* impL = (float*)(sm + L_IMP); volatile LAS unsigned* selm = (volatile LAS unsigned*)(sm + L_SELM); volatile LAS unsigned* misc = (volatile LAS unsigned*)(sm + L_MISC);
    const int g = wid >> 1, ql = 32 * (wid & 1) + r32, cur = qb, t = 64 * qb + ql; const size_t rb = (size_t)b * S, row = rb + t;
    bf16x8 qr[5];
#pragma unroll
    for (int d0 = 0; d0 < 4; ++d0) qr[d0] = *(const bf16x8*)(PR + row * NP + C_NQ + 64 * g + 16 * d0 + 8 * hi);
    { const short s8 = hi ? (short)0 : (short)f2bf(exp2f((float)(1 - 2 * g))); qr[4] = (bf16x8){s8, s8, 0, 0, 0, 0, 0, 0}; }
    const float g0 = sigm_f(AUX[row * 32 + 6 + 3 * g]), g1 = sigm_f(AUX[row * 32 + 7 + 3 * g]), g2 = sigm_f(AUX[row * 32 + 8 + 3 * g]);
    f32x16 o0, o1;
    float* tacc = (float*)(sm + L_TACC) + wid * 2048 + lane;
    unsigned z_ = 0u; asm volatile("" : "+v"(z_)); u32x4 kr, vr, ar = {z_, z_, z_, z_};
    const int ntc = (4 * qb + 2) / 64 + 1, khc = (t - 31) >> 4;
    const bf16* KCb = KC + (size_t)b * 128 * 64; const bf16* VCb = VC + (size_t)b * 128 * 64;
    float m = MINIT, l = 0.f;
    {
        u32x4 kr2, vr2, ar2;
        kv_issue(KCb, VCb, 64, wid, lane, kr, vr); if (wid == 0) ar = pos_aug(16 * lane + 31);
        if (ntc > 1) { kv_issue(KCb + 64 * 64, VCb + 64 * 64, 64, wid, lane, kr2, vr2); if (wid == 0) ar2 = pos_aug(16 * (64 + lane) + 31); }
        kv_commit(sm, tid, wid, lane, kr, vr, ar);
        if (ntc > 1) kv_commit(sm + STG, tid, wid, lane, kr2, vr2, ar2);
        __syncthreads();
        for (int it = 0; it < ntc; ++it) { const char* cb = sm + it * STG; f32x16 x0, x1; qk_tile(cb, qr, r32, hi, x0, x1); mask_tile(x0, x1, 0, khc - 64 * it, hi); smx_stats(x0, x1, m, l); }
        const float lt = l + __shfl_xor(l, 32); const float invl = lt > 0.f ? 1.f / lt : 0.f;
        float carry = 0.f;
#pragma unroll
        for (int i = 0; i < 16; ++i) { o0[i] = 0.f; o1[i] = 0.f; }
        for (int it = 0; it < ntc; ++it) { const char* cb = sm + it * STG;
              f32x16 x0, x1; qk_tile(cb, qr, r32, hi, x0, x1); bf16x8 vf[8]; v_load(cb + 9216, lane, hi, vf); mask_tile(x0, x1, 0, khc - 64 * it, hi);
#pragma unroll
              for (int i = 0; i < 16; ++i) { x0[i] = ex2(fmaf(x0[i], C2, -m)) * invl; x1[i] = ex2(fmaf(x1[i], C2, -m)) * invl; }
              float qs[8], lastv[8], rcv[8];
#pragma unroll
              for (int gq = 0; gq < 4; ++gq) { qs[gq] = (x0[4 * gq] + x0[4 * gq + 1]) + (x0[4 * gq + 2] + x0[4 * gq + 3]); lastv[gq] = x0[4 * gq + 3];
                                               qs[4 + gq] = (x1[4 * gq] + x1[4 * gq + 1]) + (x1[4 * gq + 2] + x1[4 * gq + 3]); lastv[4 + gq] = x1[4 * gq + 3]; }
#pragma unroll
              for (int gq = 0; gq < 8; ++gq) rcv[gq] = __shfl_xor(lastv[gq], 32);
#pragma unroll
              for (int gq = 0; gq < 8; ++gq) {
                  const float add0 = gq > 0 ? rcv[gq - 1] : carry;
                  const float val = qs[gq] + (hi ? rcv[gq] : add0);
                  impL[(g * 64 + ql) * 33 + 16 * it + 2 * gq + hi] = val;
              }
              carry = rcv[7];
              pv_tile(vf, x0, x1, o0, o1); }
        __syncthreads();
#pragma unroll
        for (int i = 0; i < 16; ++i) { tacc[i * 64] = g0 * o0[i]; tacc[(16 + i) * 64] = g0 * o1[i]; }
    }
    if (wid == 0) {
        const unsigned forced = 1u | (1u << cur) | (cur >= 1 ? (1u << (cur - 1)) : 0u);
        unsigned selbits = forced; const int ncand = cur - 2;
        if (ncand > 0) {
            const int nfree = 8 - __popc(forced);
            if (ncand <= nfree) selbits |= ((1u << (cur - 1)) - 2u);
            else {
                float* rowp = impL + lane * 33;
                for (int j = 1; j <= cur - 2; ++j) rowp[j] = ((rowp[j] + impL[(64 + lane) * 33 + j]) + impL[(128 + lane) * 33 + j]) + impL[(192 + lane) * 33 + j];
                for (int r = 0; r < nfree; ++r) { float best = -1.f; int bj = 1;
                    for (int j = 1; j <= cur - 2; ++j) { const float v = rowp[j]; if (v > best) { best = v; bj = j; } }
                    selbits |= 1u << bj; rowp[bj] = -2.f; }
            }
        }
        selm[lane] = selbits;
        unsigned any = selbits;
#pragma unroll
        for (int o = 1; o < 64; o <<= 1) any |= (unsigned)__shfl_xor((int)any, o);
        if (lane == 0) misc[1] = any;
    }
    __syncthreads();
    {
        const unsigned anym = misc[1] & ((2u << cur) - 1u); const unsigned mysel = selm[ql];
        const int nts = __popc(anym);
        const bf16* Kb = PR + rb * NP + C_NKS; const bf16* Vb = PR + rb * NP + C_NVS;
        m = MINIT; l = 0.f;
#pragma unroll
        for (int i = 0; i < 16; ++i) { o0[i] = 0.f; o1[i] = 0.f; }
        for (int it_ = -1, nt_ = (nts); it_ < nt_; ++it_) {
        const bool more_ = it_ + 1 < nt_;
        if (more_) { const int it = it_ + 1; { const int j = nth_set_desc(anym, it); kv_issue(Kb + (size_t)(64 * j) * NP, Vb + (size_t)(64 * j) * NP, NP, wid, lane, kr, vr); if (wid == 0) ar = pos_aug(64 * j + lane); } }
        if (it_ >= 0) { const int it = it_; const char* cb = sm + (it & 1) * STG; { const int j = nth_set_desc(anym, it);
              f32x16 x0, x1; qk_tile(cb, qr, r32, hi, x0, x1); bf16x8 vf[8]; v_load(cb + 9216, lane, hi, vf);
              const bool selj = ((mysel >> j) & 1u) != 0u;
              if (j == cur) mask_tile(x0, x1, 0, selj ? t - 64 * j : -1, hi);
              smx_tile_sel(x0, x1, m, l, o0, o1, selj || j == cur);
              pv_tile(vf, x0, x1, o0, o1); } }
        if (more_) kv_commit(sm + ((it_ + 1) & 1) * STG, tid, wid, lane, kr, vr, ar);
        __syncthreads();
    }

        const float lt = l + __shfl_xor(l, 32); const float sc = lt > 0.f ? g1 / lt : 0.f;
#pragma unroll
        for (int i = 0; i < 16; ++i) { tacc[i * 64] += sc * o0[i]; tacc[(16 + i) * 64] += sc * o1[i]; }
    }
    u32x4 zpre[2];
    {
        const int j0 = cur >= 8 ? cur - 8 : 0;
        const bf16* Kb = PR + rb * NP + C_NKW; const bf16* Vb = PR + rb * NP + C_NVW;
        m = MINIT; l = 0.f;
#pragma unroll
        for (int i = 0; i < 16; ++i) { o0[i] = 0.f; o1[i] = 0.f; }
        for (int it_ = -1, nt_ = (cur - j0 + 1); it_ < nt_; ++it_) {
        const bool more_ = it_ + 1 < nt_;
        if (!more_) { const bf16* zrow0 = PR + (rb + 64 * qb + 32 * (wid & 1)) * NP + C_NZ + 64 * g;
#pragma unroll
            for (int j = 0; j < 2; ++j) zpre[j] = *(const u32x4*)(zrow0 + (size_t)((lane >> 3) + 8 * j) * NP + 8 * (lane & 7)); }
        if (more_) { const int it = it_ + 1; { const int j = cur - it; kv_issue(Kb + (size_t)(64 * j) * NP, Vb + (size_t)(64 * j) * NP, NP, wid, lane, kr, vr); if (wid == 0) ar = pos_aug(64 * j + lane); } }
        if (it_ >= 0) { const int it = it_; const char* cb = sm + (it & 1) * STG; { const int j = cur - it;
              f32x16 x0, x1; qk_tile(cb, qr, r32, hi, x0, x1); bf16x8 vf[8]; v_load(cb + 9216, lane, hi, vf);
              if (j == cur || j == cur - 8) mask_tile(x0, x1, t - 511 - 64 * j, t - 64 * j, hi);
              smx_tile(x0, x1, m, l, o0, o1);
              pv_tile(vf, x0, x1, o0, o1); } }
        if (more_) kv_commit(sm + ((it_ + 1) & 1) * STG, tid, wid, lane, kr, vr, ar);
        __syncthreads();
    }

        const float lt = l + __shfl_xor(l, 32); const float sc = lt > 0.f ? g2 / lt : 0.f;
#pragma unroll
        for (int i = 0; i < 16; ++i) { o0[i] = tacc[i * 64] + sc * o0[i]; o1[i] = tacc[(16 + i) * 64] + sc * o1[i]; }
    }
    { const size_t r0 = rb + 64 * qb + 32 * (wid & 1);
      write_out_zh(o0, o1, 1.f, zpre, PR + r0 * NP + C_NZ + 64 * g, NP, MIX + r0 * D + 768 + 64 * g, D, (float*)(sm + L_TACC) + wid * 2048, lane); }
}

struct EpiProj {
    static constexpr bool PERM = true, AFTER_DRAIN = false;
    bf16* O; float* aux;
    __device__ __forceinline__ void operator()(const f32x4 (&acc)[2][2][4][2], const pg8::Unit& u, int wr, int wc, int fr, int fq) const {
        const int row0 = u.pm * 256 + wr * 64 + fr, col0 = u.pn * 256 + wc * 32 + 8 * fq;
#pragma unroll
        for (int ai = 0; ai < 2; ++ai)
#pragma unroll
            for (int m = 0; m < 4; ++m) { bf16* rowp = O + (size_t)(row0 + ai * 128 + m * 16) * NP + col0;
#pragma unroll
                for (int bj = 0; bj < 2; ++bj) { const f32x4 v0 = acc[ai][bj][m][0], v1 = acc[ai][bj][m][1];
                    u32x4 w; w.x = cvtpk(v0[0], v0[1]); w.y = cvtpk(v0[2], v0[3]); w.z = cvtpk(v1[0], v1[1]); w.w = cvtpk(v1[2], v1[3]);
                    *(u32x4*)(rowp + bj * 128) = w; } }
        if (u.pn == 15 && wc == 0) {
#pragma unroll
            for (int ai = 0; ai < 2; ++ai)
#pragma unroll
                for (int m = 0; m < 4; ++m) { float* ap = aux + (size_t)(row0 + ai * 128 + m * 16) * 32 + 8 * fq;
                    *(f32x4*)ap = acc[ai][1][m][0]; *(f32x4*)(ap + 4) = acc[ai][1][m][1]; }
        }
    }
};
struct EpiOut {
    static constexpr bool PERM = true, AFTER_DRAIN = false;
    const float* X; float* O;
    __device__ __forceinline__ void operator()(const f32x4 (&acc)[2][2][4][2], const pg8::Unit& u, int wr, int wc, int fr, int fq) const {
        const int row0 = u.pm * 256 + wr * 64 + fr, col0 = u.pn * 256 + wc * 32 + 8 * fq;
#pragma unroll
        for (int ai = 0; ai < 2; ++ai)
#pragma unroll
            for (int m = 0; m < 4; ++m)
#pragma unroll
                for (int bj = 0; bj < 2; ++bj) { const size_t idx = (size_t)(row0 + ai * 128 + m * 16) * D + col0 + bj * 128;
                    const f32x4 a = *(const f32x4*)(X + idx), c = *(const f32x4*)(X + idx + 4);
                    *(f32x4*)(O + idx) = a + acc[ai][bj][m][0]; *(f32x4*)(O + idx + 4) = c + acc[ai][bj][m][1]; }
    }
};

DI int src_col(int np) {
    if (np < 1152) return np;
    if (np < 3712) return np + 6;
    if (np < 3968) return np + 18;
    if (np < 3974) return 1152 + (np - 3968);
    if (np < 3986) return 3718 + (np - 3974);
    return -1;
}
DI void transpose_item(const float* W, int K, int N, bf16* WT, int nblk, bool perm, float* scr, int item, int lane) {
    const int kb = item / nblk, nb = item % nblk, k0 = 64 * kb, n0 = 32 * nb;
    const int np = n0 + (lane & 31); const int sc = perm ? src_col(np) : np;
    float wv[32];
#pragma unroll
    for (int i = 0; i < 32; ++i) { const int kk = 2 * i + (lane >> 5); wv[i] = sc >= 0 ? W[(size_t)(k0 + kk) * N + sc] : 0.f; }
#pragma unroll
    for (int i = 0; i < 32; ++i) { const int kk = 2 * i + (lane >> 5); scr[kk * 33 + (lane & 31)] = wv[i]; }
    __builtin_amdgcn_s_waitcnt(0); __builtin_amdgcn_wave_barrier();
    const int c = lane & 7;
#pragma unroll
    for (int j = 0; j < 4; ++j) { const int n = (lane >> 3) + 8 * j; const float* s = scr + (8 * c) * 33 + n;
        u32x4 o; o.x = cvtpk(s[0 * 33], s[1 * 33]); o.y = cvtpk(s[2 * 33], s[3 * 33]); o.z = cvtpk(s[4 * 33], s[5 * 33]); o.w = cvtpk(s[6 * 33], s[7 * 33]);
        *(u32x4*)(WT + (size_t)(n0 + n) * K + k0 + 8 * c) = o; }
    __builtin_amdgcn_s_waitcnt(0); __builtin_amdgcn_wave_barrier();
}
DI void norm_row_bf16(const float* xrow, const float* gw, bf16* orow, int lane) {
    f32x4 v[4]; float s = 0.f;
#pragma unroll
    for (int j = 0; j < 4; ++j) { v[j] = *(const f32x4*)(xrow + 4 * lane + 256 * j); s += (v[j].x * v[j].x + v[j].y * v[j].y) + (v[j].z * v[j].z + v[j].w * v[j].w); }
    const float rs = 1.f / sqrtf(wave_sum(s) * (1.f / D) + 1e-6f);
#pragma unroll
    for (int j = 0; j < 4; ++j) { const f32x4 gg = *(const f32x4*)(gw + 4 * lane + 256 * j);
        u32x2 w; w.x = cvtpk(v[j].x * rs * gg.x, v[j].y * rs * gg.y); w.y = cvtpk(v[j].z * rs * gg.z, v[j].w * rs * gg.w);
        *(u32x2*)(orow + 4 * lane + 256 * j) = w; }
}
DI void norm_row_f32(float* xrow, const float* gw, int lane) {
    f32x4 v[4]; float s = 0.f;
#pragma unroll
    for (int j = 0; j < 4; ++j) { v[j] = *(const f32x4*)(xrow + 4 * lane + 256 * j); s += (v[j].x * v[j].x + v[j].y * v[j].y) + (v[j].z * v[j].z + v[j].w * v[j].w); }
    const float rs = 1.f / sqrtf(wave_sum(s) * (1.f / D) + 1e-6f);
#pragma unroll
    for (int j = 0; j < 4; ++j) { const f32x4 gg = *(const f32x4*)(gw + 4 * lane + 256 * j);
        *(f32x4*)(xrow + 4 * lane + 256 * j) = (f32x4){v[j].x * rs * gg.x, v[j].y * rs * gg.y, v[j].z * rs * gg.z, v[j].w * rs * gg.w}; }
}

template <bool BF> DI void norm_rows4(float* src, const float* gw, bf16* dstb, int r0, int stride, int lane) {
    f32x4 v[4][4];
#pragma unroll
    for (int k = 0; k < 4; ++k) { const int r = r0 + k * stride;
#pragma unroll
        for (int j = 0; j < 4; ++j) v[k][j] = r < M ? *(const f32x4*)(src + (size_t)r * D + 4 * lane + 256 * j) : (f32x4){0.f, 0.f, 0.f, 0.f}; }
    f32x4 gg[4];
#pragma unroll
    for (int j = 0; j < 4; ++j) gg[j] = *(const f32x4*)(gw + 4 * lane + 256 * j);
#pragma unroll
    for (int k = 0; k < 4; ++k) { const int r = r0 + k * stride; float s = 0.f;
#pragma unroll
        for (int j = 0; j < 4; ++j) s += (v[k][j].x * v[k][j].x + v[k][j].y * v[k][j].y) + (v[k][j].z * v[k][j].z + v[k][j].w * v[k][j].w);
        const float rs = 1.f / sqrtf(wave_sum(s) * (1.f / D) + 1e-6f);
        if (r < M) {
#pragma unroll
            for (int j = 0; j < 4; ++j) {
                const f32x4 y = (f32x4){v[k][j].x * rs * gg[j].x, v[k][j].y * rs * gg[j].y, v[k][j].z * rs * gg[j].z, v[k][j].w * rs * gg[j].w};
                if (BF) { u32x2 w; w.x = cvtpk(y.x, y.y); w.y = cvtpk(y.z, y.w); *(u32x2*)(dstb + (size_t)r * D + 4 * lane + 256 * j) = w; }
                else *(f32x4*)(src + (size_t)r * D + 4 * lane + 256 * j) = y;
            }
        }
    }
}

struct Params { const float *x, *norm_g, *w_in, *b_f, *pos_k, *w1_k, *w2_k, *pos_v, *w1_v, *w2_v, *w_out, *final_g; float* out; unsigned char* ws; };

DI int next_unit(unsigned* ctr, char* sm) {
    volatile LAS int* slot = (volatile LAS int*)(sm + L_MISC);
    __syncthreads();
    if (threadIdx.x == 0) *slot = (int)atomicAdd(ctr, 1u);
    __syncthreads();
    return *slot;
}

#define XB_TMO      128
#define XB_XCNT(j)  (256  + 64 * (j))
#define XB_XSUB(j)  (1280 + 64 * (j))
#define XB_XGEN(j)  (2304 + 64 * (j))
#define XB_TOP      3328
#define XB_TOPGEN   3392
#define XCD_BAR_WORDS 3456
#define XB_SPIN_CAP (1u << 18)

__device__ __forceinline__ unsigned xb_ld(unsigned* p)              { return __hip_atomic_load(p, __ATOMIC_RELAXED, __HIP_MEMORY_SCOPE_AGENT); }
__device__ __forceinline__ unsigned xb_add(unsigned* p, unsigned v) { return __hip_atomic_fetch_add(p, v, __ATOMIC_RELAXED, __HIP_MEMORY_SCOPE_AGENT); }
__device__ __forceinline__ unsigned xb_xcc_id() { return (unsigned)__builtin_amdgcn_s_getreg((3 << 11) | 20) & 0xFu; }
#define XB_SPIN(cond, bar) do { unsigned _sp = 0; while (cond) { __builtin_amdgcn_s_sleep(1); \
    if ((++_sp & 255u) == 0u) { if (xb_ld(&(bar)[XB_TMO])) break; if (_sp > XB_SPIN_CAP) { atomicAdd(&(bar)[XB_TMO], 1u); break; } } } } while (0)

struct XcdBarrier {
    unsigned* bar; unsigned x;
    volatile LAS unsigned* st;
};

__device__ __forceinline__ XcdBarrier xcd_barrier_post(unsigned* bar, volatile LAS unsigned* st) {
    XcdBarrier b; b.bar = bar; b.x = xb_xcc_id(); b.st = st;
    if (threadIdx.x == 0) (void)xb_add(&bar[XB_XCNT(b.x)], 1u);
    return b;
}
__device__ __forceinline__ void xcd_barrier_complete(unsigned* bar, unsigned x, unsigned& nloc, unsigned& nx) {
    const unsigned G = gridDim.x * gridDim.y * gridDim.z;
    unsigned sum, cnt, mine, sp = 0u;
    for (;;) {
        sum = 0u; cnt = 0u; mine = 0u;
#pragma unroll
        for (unsigned j = 0; j < 16; ++j) { const unsigned c = xb_ld(&bar[XB_XCNT(j)]); sum += c; cnt += (c > 0u) ? 1u : 0u; mine = (j == x) ? c : mine; }
        if (sum == G) break;
        __builtin_amdgcn_s_sleep(1);
        if ((++sp & 255u) == 0u) { if (xb_ld(&bar[XB_TMO])) break; if (sp > XB_SPIN_CAP) { atomicAdd(&bar[XB_TMO], 1u); break; } }
    }
    nloc = mine > 0u ? mine : 1u; nx = cnt > 0u ? cnt : 1u;
}

__device__ __forceinline__ void xcd_barrier(const XcdBarrier& b) {
    asm volatile("s_waitcnt vmcnt(0)" ::: "memory");
    __syncthreads();
    if (threadIdx.x == 0) {
        unsigned* bar = b.bar;
        __builtin_amdgcn_s_waitcnt(0);
        unsigned nloc = b.st[0], nx = b.st[1];
        if (nloc == 0u) { xcd_barrier_complete(bar, b.x, nloc, nx); b.st[0] = nloc; b.st[1] = nx; }
        const unsigned old = xb_add(&bar[XB_XSUB(b.x)], 1u);
        const unsigned gen = old / nloc;
        if (old + 1u == (gen + 1u) * nloc) {
            __builtin_amdgcn_fence(__ATOMIC_RELEASE, "agent");
            asm volatile("s_waitcnt vmcnt(0)" ::: "memory");
            const unsigned og = xb_add(&bar[XB_TOP], 1u);
            const unsigned tg = og / nx;
            if (og + 1u == (tg + 1u) * nx) xb_add(&bar[XB_TOPGEN], 1u);
            else XB_SPIN(xb_ld(&bar[XB_TOPGEN]) == tg, bar);
            __builtin_amdgcn_fence(__ATOMIC_ACQUIRE, "agent");
            xb_add(&bar[XB_XGEN(b.x)], 1u);
            asm volatile("s_waitcnt vmcnt(0)" ::: "memory");
        } else {
            XB_SPIN(xb_ld(&bar[XB_XGEN(b.x)]) == gen, bar);
            __builtin_amdgcn_fence(__ATOMIC_ACQUIRE, "agent");
            asm volatile("s_waitcnt vmcnt(0)" ::: "memory");
        }
    }
    __syncthreads();
}

__global__ void __launch_bounds__(512, 2) mega_fwd(Params p) {
    extern __shared__ __attribute__((aligned(16))) unsigned char smem[];
    cg::grid_group grid = cg::this_grid();
    char* sm = (char*)smem;
    int tid_ = threadIdx.x; asm volatile("" : "+v"(tid_)); const int tid = tid_, lane = tid & 63, wid = __builtin_amdgcn_readfirstlane(tid >> 6);
    const int G = gridDim.x, gw = blockIdx.x * 8 + wid, NGW = G * 8;
    unsigned char* ws = p.ws;
    unsigned* ctl = (unsigned*)(ws + WS_CTL);
    volatile LAS unsigned* XBW = (volatile LAS unsigned*)(sm + L_XB);
    if (threadIdx.x == 0) { XBW[0] = 0u; XBW[1] = 0u; }
    __syncthreads();
    const XcdBarrier xbar = xcd_barrier_post(ctl + 1024, XBW);
    bf16* WTIN = (bf16*)(ws + WS_WTIN); bf16* WTOUT = (bf16*)(ws + WS_WTOUT); bf16* W1T = (bf16*)(ws + WS_W1T); bf16* W2T = (bf16*)(ws + WS_W2T);
    float* PB = (float*)(ws + WS_PB); bf16* KC = (bf16*)(ws + WS_KC); bf16* VC = (bf16*)(ws + WS_VC); float* AUX = (float*)(ws + WS_AUX);
    bf16* H = (bf16*)(ws + WS_H); bf16* PROJ = (bf16*)(ws + WS_PROJ);

    {
        float* scr = (float*)(sm + wid * 16384);
        constexpr int I_IN = 16 * 128, I_OUT = 16 * 32, I_W1 = 32 * 2, I_W2 = 2;
        constexpr int NITEMS = 2 * I_IN + 2 * I_OUT + 4 * I_W1 + 4 * I_W2;
        for (int it = gw; it < NITEMS; it += NGW) {
            int r = it;
            if (r < 2 * I_IN) { const int l = r / I_IN; transpose_item(p.w_in + (size_t)l * D * DIN, D, DIN, WTIN + (size_t)l * NP * D, 128, true, scr, r % I_IN, lane); continue; } r -= 2 * I_IN;
            if (r < 2 * I_OUT) { const int l = r / I_OUT; transpose_item(p.w_out + (size_t)l * D * D, D, D, WTOUT + (size_t)l * D * D, 32, false, scr, r % I_OUT, lane); continue; } r -= 2 * I_OUT;
            if (r < 4 * I_W1) { const int q = r / I_W1, l = q >> 1, kv = q & 1; transpose_item((kv ? p.w1_v : p.w1_k) + (size_t)l * 2048 * 64, 2048, 64, W1T + (size_t)q * 64 * 2048, 2, false, scr, r % I_W1, lane); continue; } r -= 4 * I_W1;
            { const int q = r / I_W2, l = q >> 1, kv = q & 1; transpose_item((kv ? p.w2_v : p.w2_k) + (size_t)l * 64 * 64, 64, 64, W2T + (size_t)q * 64 * 64, 2, false, scr, r % I_W2, lane); }
        }
        for (int it = gw; it < 256; it += NGW) {
            const int q = it >> 6, e = it & 63, l = q >> 1, kv = q & 1;
            const float* pos = (kv ? p.pos_v : p.pos_k) + (size_t)l * 2048; const float* w1 = (kv ? p.w1_v : p.w1_k) + (size_t)l * 2048 * 64;
            float s = 0.f;
            for (int f = lane; f < 2048; f += 64) s += pos[f] * w1[(size_t)f * 64 + e];
            s = wave_sum(s);
            if (lane == 0) PB[it] = s;
        }
        for (int r = gw; r < M; r += 4 * NGW) norm_rows4<true>(const_cast<float*>(p.x), p.norm_g, H, r, NGW, lane);
    }
    if (gridDim.y == 0x7fffu) grid.sync();
    xcd_barrier(XcdBarrier{ctl + 1024, xb_xcc_id(), (volatile LAS unsigned*)(sm + L_XB)});

    for (int l = 0; l < 2; ++l) {
        for (int rep1 = 0; rep1 < REP_P1; ++rep1) {
            pg8::Gemm g{H, WTIN + (size_t)l * NP * D, M, NP, D}; pg8::StaticOrder So; So.init(M, NP, G, (int)blockIdx.x);
            EpiProj E{PROJ, AUX};
            pg8::gemm_phase<EpiProj, pg8::StaticOrder, true, true>((PG8_LAS unsigned char*)smem, g, So, E);
        }
        xcd_barrier(XcdBarrier{ctl + 1024, xb_xcc_id(), (volatile LAS unsigned*)(sm + L_XB)});
        for (int u = next_unit(ctl + 2 * l, sm); u < 2816;) {
            int nxt_ = 0; if (threadIdx.x == 0) nxt_ = (int)atomicAdd(ctl + 2 * l, 1u);
            if (u < 768) { const int k = u / 192, bh = u % 192;
                fox_unit(PROJ, AUX, p.b_f + 6 * l, H, sm, bh / 6, bh % 6, 7 - k, true); fox_unit(PROJ, AUX, p.b_f + 6 * l, H, sm, bh / 6, bh % 6, k, false); }
            else if (u < 2304) { const int v = u - 768; const int qb = 7 - v / 192, bh = v % 192; sb_unit(PROJ, H, sm, bh / 6, bh % 6, qb); }
            else { const int v = u - 2304; const int b = v >> 4, kv = (v >> 3) & 1, nt = v & 7; const int q = 2 * l + kv;
                   cmp_unit(PROJ, W1T + (size_t)q * 64 * 2048, W2T + (size_t)q * 64 * 64, PB + q * 64, kv ? VC : KC, kv ? C_NVC : C_NKC, sm, b, nt); }
            { volatile LAS int* slot = (volatile LAS int*)(sm + L_MISC); __syncthreads(); if (threadIdx.x == 0) *slot = nxt_; __syncthreads(); u = *slot; }
        }
        xcd_barrier(XcdBarrier{ctl + 1024, xb_xcc_id(), (volatile LAS unsigned*)(sm + L_XB)});
        for (int u = next_unit(ctl + 2 * l + 1, sm); u < 1024;) {
            int nxt_ = 0; if (threadIdx.x == 0) nxt_ = (int)atomicAdd(ctl + 2 * l + 1, 1u);
            nsa_unit(PROJ, AUX, KC, VC, H, sm, u & 31, 31 - (u >> 5));
            { volatile LAS int* slot = (volatile LAS int*)(sm + L_MISC); __syncthreads(); if (threadIdx.x == 0) *slot = nxt_; __syncthreads(); u = *slot; }
        }
        xcd_barrier(XcdBarrier{ctl + 1024, xb_xcc_id(), (volatile LAS unsigned*)(sm + L_XB)});
        {
            pg8::Gemm g{H, WTOUT + (size_t)l * D * D, M, D, D}; pg8::StaticOrder So; So.init(M, D, G, (int)blockIdx.x);
            EpiOut E{l == 0 ? p.x : p.out, p.out};
            pg8::gemm_phase<EpiOut, pg8::StaticOrder, true, true>((PG8_LAS unsigned char*)smem, g, So, E);
        }
        xcd_barrier(XcdBarrier{ctl + 1024, xb_xcc_id(), (volatile LAS unsigned*)(sm + L_XB)});
        { int t5 = threadIdx.x; asm volatile("" : "+v"(t5)); const int lane5 = t5 & 63, gw5 = blockIdx.x * 8 + __builtin_amdgcn_readfirstlane(t5 >> 6);
        if (l == 0) { for (int r = gw5; r < M; r += 4 * NGW) norm_rows4<true>(p.out, p.norm_g + D, H, r, NGW, lane5); xcd_barrier(XcdBarrier{ctl + 1024, xb_xcc_id(), (volatile LAS unsigned*)(sm + L_XB)}); }
        else { for (int r = gw5; r < M; r += 4 * NGW) norm_rows4<false>(p.out, p.final_g, nullptr, r, NGW, lane5); } }
    }
}

extern "C" void kernel_launch(void* const* d_in, const int* in_sizes, int n_in, void* d_out, int out_size, void* d_ws, size_t ws_size, hipStream_t stream) {
    static int grid = 0;
    if (grid == 0) {
        if (n_in != 12 || out_size != M * D || ws_size < WS_END) { fprintf(stderr, "kernel_launch: unexpected shapes (n_in %d out %d ws %zu)\n", n_in, out_size, ws_size); grid = -1; return; }
        int dev = 0, cus = 0, per_cu = 0;
        hipGetDevice(&dev); hipDeviceGetAttribute(&cus, hipDeviceAttributeMultiprocessorCount, dev);
        if (hipFuncSetAttribute((const void*)mega_fwd, hipFuncAttributeMaxDynamicSharedMemorySize, LDS_BYTES) != hipSuccess) { fprintf(stderr, "kernel_launch: hipFuncSetAttribute failed\n"); grid = -1; return; }
        if (hipOccupancyMaxActiveBlocksPerMultiprocessor(&per_cu, (const void*)mega_fwd, 512, LDS_BYTES) != hipSuccess || per_cu < 1) { fprintf(stderr, "kernel_launch: occupancy query failed (%d)\n", per_cu); per_cu = 1; }
        (void)hipGetLastError();
        grid = cus * per_cu;
    }
    if (grid < 0) return;
    hipMemsetAsync((char*)d_ws + WS_CTL, 0, CTL_BYTES, stream);
    Params p{};
    p.x = (const float*)d_in[0]; p.norm_g = (const float*)d_in[1]; p.w_in = (const float*)d_in[2]; p.b_f = (const float*)d_in[3];
    p.pos_k = (const float*)d_in[4]; p.w1_k = (const float*)d_in[5]; p.w2_k = (const float*)d_in[6];
    p.pos_v = (const float*)d_in[7]; p.w1_v = (const float*)d_in[8]; p.w2_v = (const float*)d_in[9];
    p.w_out = (const float*)d_in[10]; p.final_g = (const float*)d_in[11]; p.out = (float*)d_out; p.ws = (unsigned char*)d_ws;
    void* args[] = {&p};
    const hipError_t e = hipLaunchCooperativeKernel((const void*)mega_fwd, dim3(grid), dim3(512), args, LDS_BYTES, stream);
    if (e != hipSuccess) fprintf(stderr, "cooperative launch failed: %s (grid %d)\n", hipGetErrorString(e), grid);
}
```
